# Optimizing an MI355X kernel written in HIP

```python
import jax, jax.numpy as jnp
from jax import lax
import numpy as np

D_MODEL = 1024
BATCH = 8
SEQ = 4096
DEPTH = 1
DEC_BATCH = 16
DEC_SEQ = 32
PAST_LEN = 4096

CHUNK = 64
MIX_WIDTH = D_MODEL
HG_WIDTH = MIX_WIDTH // 2
HG_HEADS = 4
HG_DIM = HG_WIDTH // HG_HEADS
HG_BLOCK = 16
HG_COLS = 4 * HG_WIDTH
RW_WIDTH = MIX_WIDTH - HG_WIDTH
RW_HEAD = 64
RW_HEADS = RW_WIDTH // RW_HEAD
RW_DECAY_LORA = 64
RW_A_LORA = 64
RW_GATE_LORA = 128
RW_COLS = 3 * RW_WIDTH + RW_DECAY_LORA + RW_A_LORA + RW_GATE_LORA
IN_COLS = HG_COLS + RW_COLS
N_MEM = 256
X_HEADS = 4
X_DIM = D_MODEL // X_HEADS
D_FF = -(-8 * D_MODEL // (3 * 256)) * 256
RMS_EPS = 1e-6
GN_EPS = 64e-5

kernel_name = "hgrn2_rwkv7_parallel_heads_stream_step"


def rmsnorm(x, g):
    xf = x.astype(jnp.float32)
    y = xf * lax.rsqrt(jnp.mean(xf * xf, axis=-1, keepdims=True) + RMS_EPS)
    return (y * g.astype(jnp.float32)).astype(x.dtype)


def hgrn2_chunkwise(q, logf, k, v, s0):
    bsz, t_len = q.shape[0], q.shape[1]
    pad = (-t_len) % HG_BLOCK

    def blocks(a):
        a = jnp.pad(a, ((0, 0), (0, pad), (0, 0), (0, 0)))
        return a.reshape(bsz, -1, HG_BLOCK, HG_HEADS, HG_DIM)

    q, logf, k, v = blocks(q), blocks(logf), blocks(k), blocks(v)
    b = jnp.cumsum(logf, axis=2)
    b_last = b[:, :, -1:]
    qg = q * jnp.exp(b)
    kg = k * jnp.exp(-b)
    kd = k * jnp.exp(b_last - b)
    causal = jnp.tril(jnp.ones((HG_BLOCK, HG_BLOCK), dtype=bool))
    att = jnp.where(causal, jnp.einsum('bnthk,bnshk->bnhts', qg, kg), 0.0)
    o_intra = jnp.einsum('bnhts,bnshv->bnthv', att, v)

    def step(S, xs):
        qg_n, kd_n, v_n, dec_n = xs
        o_n = jnp.einsum('bthk,bhkv->bthv', qg_n, S)
        S = dec_n[..., None] * S + jnp.einsum('bshk,bshv->bhkv', kd_n, v_n)
        return S, o_n

    blk_first = lambda a: jnp.moveaxis(a, 1, 0)
    s_final, o_inter = lax.scan(step, s0, (blk_first(qg), blk_first(kd), blk_first(v),
                                           blk_first(jnp.exp(b_last[:, :, 0]))))
    o = (o_intra + blk_first(o_inter)).reshape(bsz, -1, HG_HEADS, HG_DIM)[:, :t_len]
    return o, s_final


def hgrn2_mixer(p, lb, g_norm, s0):
    bsz, t_len = p.shape[0], p.shape[1]
    pf = p.astype(jnp.float32)
    q, fpre, i_in, g = jnp.split(pf, 4, axis=-1)
    lb = lb.astype(jnp.float32)
    logf = jnp.log(lb + (1.0 - lb) * jax.nn.sigmoid(fpre))
    k = (1.0 - lb) * jax.nn.sigmoid(-fpre)
    hv = lambda a: a.reshape(bsz, t_len, HG_HEADS, HG_DIM)
    o, s_final = hgrn2_chunkwise(hv(q), hv(logf), hv(k), hv(i_in), s0.astype(jnp.float32))
    o = o * lax.rsqrt(jnp.mean(o * o, axis=-1, keepdims=True) + RMS_EPS)
    o = o.reshape(bsz, t_len, HG_WIDTH) * g_norm.astype(jnp.float32) * jax.nn.silu(g)
    return o.astype(p.dtype), s_final.astype(p.dtype)


def rwkv7_mixer(p, shift0, s0, mu, w0, w_b, a0, a_b, g_b, k_k, k_a, r_k, gn_w, gn_b):
    bsz, t_len = p.shape[0], p.shape[1]
    prev = jnp.concatenate([shift0.astype(p.dtype), p[:, :-1]], axis=1)
    xs = (p + (prev - p) * mu).astype(jnp.float32)
    new_shift = p[:, -1:]
    cut = [RW_WIDTH, 2 * RW_WIDTH, 3 * RW_WIDTH, 3 * RW_WIDTH + RW_DECAY_LORA,
           3 * RW_WIDTH + RW_DECAY_LORA + RW_A_LORA]
    r, k, v, wd, ad, gd = jnp.split(xs, cut, axis=-1)
    w = -jax.nn.softplus(-(w0 + jnp.tanh(wd) @ w_b)) - 0.5
    decay = jnp.exp(-jnp.exp(w))
    a = jax.nn.sigmoid(a0 + ad @ a_b)
    g = jax.nn.sigmoid(gd) @ g_b
    kk = k * k_k
    k = k * (1.0 + (a - 1.0) * k_a)
    hv = lambda t: t.reshape(bsz, t_len, RW_HEADS, RW_HEAD)
    r, k, v, a, decay, kk = hv(r), hv(k), hv(v), hv(a), hv(decay), hv(kk)
    kk = kk / jnp.maximum(jnp.sqrt(jnp.sum(kk * kk, axis=-1, keepdims=True)), 1e-12)

    def step(S, xs_t):
        r_t, w_t, k_t, v_t, kk_t, a_t = xs_t
        sa = jnp.einsum('bhvk,bhk->bhv', S, -kk_t)
        S = (S * w_t[:, :, None, :] + sa[..., None] * (kk_t * a_t)[:, :, None, :]
             + v_t[..., None] * k_t[:, :, None, :])
        return S, jnp.einsum('bhvk,bhk->bhv', S, r_t)

    tm = lambda t: jnp.moveaxis(t, 1, 0)
    s_final, y = lax.scan(step, s0.astype(jnp.float32), (tm(r), tm(decay), tm(k), tm(v), tm(kk), tm(a)))
    y = jnp.moveaxis(y, 0, 1)
    mean = jnp.mean(y, axis=-1, keepdims=True)
    var = jnp.mean(jnp.square(y - mean), axis=-1, keepdims=True)
    y = ((y - mean) * lax.rsqrt(var + GN_EPS)).reshape(bsz, t_len, RW_WIDTH) * gn_w + gn_b
    bonus = jnp.sum(r * k * r_k, axis=-1, keepdims=True) * v
    y = (y + bonus.reshape(bsz, t_len, RW_WIDTH)) * g
    return y.astype(p.dtype), s_final.astype(p.dtype), new_shift


def memory_kv(mem, g_mem, w_k, w_v):
    bsz = mem.shape[0]
    nm = rmsnorm(mem, g_mem)
    mk = (nm @ w_k).reshape(bsz, N_MEM, X_HEADS, X_DIM)
    mv = (nm @ w_v).reshape(bsz, N_MEM, X_HEADS, X_DIM)
    return mk, mv


def cross_attend(n, mk, mv, w_q, w_o):
    bsz, t_len = n.shape[0], n.shape[1]
    q = (n @ w_q).reshape(bsz, t_len, X_HEADS, X_DIM).astype(jnp.float32)
    s = jnp.einsum('bthd,bmhd->bhtm', q, mk.astype(jnp.float32)) * (X_DIM ** -0.5)
    pr = jax.nn.softmax(s, axis=-1)
    o = jnp.einsum('bhtm,bmhd->bthd', pr, mv.astype(jnp.float32)).astype(n.dtype)
    return o.reshape(bsz, t_len, D_MODEL) @ w_o


def layer(x, mk, mv, hg_s0, rw_s0, shift0, lb, lw):
    n = rmsnorm(x, lw['norm_mix'])
    p = n @ lw['w_in']
    hg_o, hg_s = hgrn2_mixer(p[..., :HG_COLS], lb, lw['hgrn_norm'], hg_s0)
    rw_o, rw_s, rw_shift = rwkv7_mixer(p[..., HG_COLS:], shift0, rw_s0, lw['rw_mu'], lw['rw_w0'], lw['rw_w_b'],
                                       lw['rw_a0'], lw['rw_a_b'], lw['rw_g_b'], lw['rw_k_k'], lw['rw_k_a'],
                                       lw['rw_r_k'], lw['rw_gn_w'], lw['rw_gn_b'])
    x = x + jnp.concatenate([hg_o, rw_o], axis=-1) @ lw['w_out']
    x = x + cross_attend(rmsnorm(x, lw['norm_cross']), mk, mv, lw['w_cq'], lw['w_co'])
    n = rmsnorm(x, lw['norm_ffn'])
    x = x + (jax.nn.silu(n @ lw['w_ff1']) * (n @ lw['w_ff3'])) @ lw['w_ff2']
    return x, hg_s, rw_s, rw_shift


def setup_inputs(seed: int = 0) -> dict:
    key = jax.random.key(seed)
    ks = jax.random.split(key, 40)
    nrm = lambda i, shape, scale: jax.random.normal(ks[i], shape, jnp.float32) * scale
    D = D_MODEL
    return {
        'x_prompt': nrm(0, (BATCH, SEQ, D), 1.0),
        'mem_prompt': nrm(1, (BATCH, N_MEM, D), 1.0),
        'x_sample': nrm(2, (DEC_BATCH, DEC_SEQ, D), 1.0),
        'cache_mem_k': nrm(3, (DEPTH, DEC_BATCH, N_MEM, X_HEADS, X_DIM), 1.0),
        'cache_mem_v': nrm(4, (DEPTH, DEC_BATCH, N_MEM, X_HEADS, X_DIM), 1.0),
        'state_hgrn': nrm(5, (DEPTH, DEC_BATCH, HG_HEADS, HG_DIM, HG_DIM), 0.5),
        'state_rwkv': nrm(6, (DEPTH, DEC_BATCH, RW_HEADS, RW_HEAD, RW_HEAD), 0.5),
        'state_rwkv_shift': nrm(7, (DEPTH, DEC_BATCH, 1, RW_COLS), 1.0),
        'hgrn_lb_logits': nrm(8, (DEPTH + 1, HG_WIDTH), 0.1),
        'norm_mix': 1.0 + nrm(9, (DEPTH, D), 0.02),
        'w_in': nrm(10, (DEPTH, D, IN_COLS), D ** -0.5),
        'hgrn_norm': 1.0 + nrm(11, (DEPTH, HG_WIDTH), 0.02),
        'rw_mu': jax.random.uniform(ks[12], (DEPTH, RW_COLS), jnp.float32),
        'rw_w0': jax.random.uniform(ks[13], (DEPTH, RW_WIDTH), jnp.float32, -2.5, 0.5),
        'rw_w_b': nrm(14, (DEPTH, RW_DECAY_LORA, RW_WIDTH), 0.1),
        'rw_a0': nrm(15, (DEPTH, RW_WIDTH), 0.1),
        'rw_a_b': nrm(16, (DEPTH, RW_A_LORA, RW_WIDTH), 0.1),
        'rw_g_b': nrm(17, (DEPTH, RW_GATE_LORA, RW_WIDTH), RW_GATE_LORA ** -0.5),
        'rw_k_k': 0.85 + nrm(18, (DEPTH, RW_WIDTH), 0.02),
        'rw_k_a': 1.0 + nrm(19, (DEPTH, RW_WIDTH), 0.02),
        'rw_r_k': nrm(20, (DEPTH, RW_HEADS, RW_HEAD), 0.1),
        'rw_gn_w': 1.0 + nrm(21, (DEPTH, RW_WIDTH), 0.02),
        'rw_gn_b': nrm(22, (DEPTH, RW_WIDTH), 0.01),
        'w_out': nrm(23, (DEPTH, MIX_WIDTH, D), MIX_WIDTH ** -0.5),
        'norm_cross': 1.0 + nrm(24, (DEPTH, D), 0.02),
        'norm_mem': 1.0 + nrm(25, (DEPTH, D), 0.02),
        'w_cq': nrm(26, (DEPTH, D, D), D ** -0.5),
        'w_ck': nrm(27, (DEPTH, D, D), D ** -0.5),
        'w_cv': nrm(28, (DEPTH, D, D), D ** -0.5),
        'w_co': nrm(29, (DEPTH, D, D), D ** -0.5),
        'norm_ffn': 1.0 + nrm(30, (DEPTH, D), 0.02),
        'w_ff1': nrm(31, (DEPTH, D, D_FF), D ** -0.5),
        'w_ff3': nrm(32, (DEPTH, D, D_FF), D ** -0.5),
        'w_ff2': nrm(33, (DEPTH, D_FF, D), D_FF ** -0.5),
        'norm_final': 1.0 + nrm(34, (D,), 0.02),
    }


def reference(x_prompt, mem_prompt, x_sample, cache_mem_k, cache_mem_v, state_hgrn, state_rwkv, state_rwkv_shift,
              hgrn_lb_logits, norm_mix, w_in, hgrn_norm, rw_mu, rw_w0, rw_w_b, rw_a0, rw_a_b, rw_g_b, rw_k_k, rw_k_a,
              rw_r_k, rw_gn_w, rw_gn_b, w_out, norm_cross, norm_mem, w_cq, w_ck, w_cv, w_co, norm_ffn, w_ff1, w_ff3,
              w_ff2, norm_final):
    lb_table = jnp.cumsum(jax.nn.softmax(hgrn_lb_logits.astype(jnp.float32), axis=0), axis=0)
    bp = x_prompt.shape[0]
    xp, xs = x_prompt, x_sample
    p_hg, p_rw, p_sh, p_mk, p_mv, s_hg, s_rw, s_sh = [], [], [], [], [], [], [], []
    for l in range(DEPTH):
        lw = {'norm_mix': norm_mix[l], 'w_in': w_in[l], 'hgrn_norm': hgrn_norm[l], 'rw_mu': rw_mu[l],
              'rw_w0': rw_w0[l], 'rw_w_b': rw_w_b[l], 'rw_a0': rw_a0[l], 'rw_a_b': rw_a_b[l], 'rw_g_b': rw_g_b[l],
              'rw_k_k': rw_k_k[l], 'rw_k_a': rw_k_a[l], 'rw_r_k': rw_r_k[l], 'rw_gn_w': rw_gn_w[l],
              'rw_gn_b': rw_gn_b[l], 'w_out': w_out[l], 'norm_cross': norm_cross[l], 'w_cq': w_cq[l],
              'w_co': w_co[l], 'norm_ffn': norm_ffn[l], 'w_ff1': w_ff1[l], 'w_ff3': w_ff3[l], 'w_ff2': w_ff2[l]}
        lb = lb_table[l]
        mk, mv = memory_kv(mem_prompt, norm_mem[l], w_ck[l], w_cv[l])
        hg0 = jnp.zeros((bp, HG_HEADS, HG_DIM, HG_DIM), xp.dtype)
        rw0 = jnp.zeros((bp, RW_HEADS, RW_HEAD, RW_HEAD), xp.dtype)
        sh0 = jnp.zeros((bp, 1, RW_COLS), xp.dtype)
        xp, hg_new, rw_new, sh_new = layer(xp, mk, mv, hg0, rw0, sh0, lb, lw)
        p_hg.append(hg_new); p_rw.append(rw_new); p_sh.append(sh_new); p_mk.append(mk); p_mv.append(mv)
        xs, hg_new, rw_new, sh_new = layer(xs, cache_mem_k[l], cache_mem_v[l], state_hgrn[l], state_rwkv[l],
                                           state_rwkv_shift[l], lb, lw)
        s_hg.append(hg_new); s_rw.append(rw_new); s_sh.append(sh_new)
    y_prompt = rmsnorm(xp, norm_final)
    y_sample = rmsnorm(xs, norm_final)
    return (y_prompt, y_sample, jnp.stack(p_hg), jnp.stack(p_rw), jnp.stack(p_sh), jnp.stack(p_mk),
            jnp.stack(p_mv), jnp.stack(s_hg), jnp.stack(s_rw), jnp.stack(s_sh))
```

```cpp
#include <hip/hip_runtime.h>
#include <hip/hip_cooperative_groups.h>
#include <cstdio>
namespace cg = cooperative_groups;

#ifndef MK_MULTI
#define MK_MULTI 0
#endif

#define LAS __attribute__((address_space(3)))
typedef unsigned short bf16_t;
typedef short bf16x8 __attribute__((ext_vector_type(8)));
typedef float f32x4 __attribute__((ext_vector_type(4)));
typedef float f32x2 __attribute__((ext_vector_type(2)));
typedef unsigned u32x4 __attribute__((ext_vector_type(4)));
typedef unsigned u32x2 __attribute__((ext_vector_type(2)));

constexpr int D = 1024, NTOKP = 32768, NTOKS = 512, NTOK = 33280, HGC = 2048, RWC = 1792, DFF = 2816;
constexpr int NPHASE = 13;
constexpr int LDS_BYTES = 131072 + 16;

constexpr size_t O_Y = 0, O_PHG = 34078720, O_PRW = 34603008, O_PSH = 34865152, O_PMK = 34879488, O_PMV = 36976640,
                 O_SHG = 39073792, O_SRW = 40122368, O_SSH = 40646656;
constexpr size_t WS_WIN = 0;
constexpr size_t WS_WLORA = WS_WIN + 7864320;
constexpr size_t WS_WOUT = WS_WLORA + 786432;
constexpr size_t WS_WCQ = WS_WOUT + 2097152;
constexpr size_t WS_WKV = WS_WCQ + 2097152;
constexpr size_t WS_WCO = WS_WKV + 4194304;
constexpr size_t WS_WFF13 = WS_WCO + 2097152;
constexpr size_t WS_WFF2 = WS_WFF13 + 11534336;
constexpr size_t WS_PHG = WS_WFF2 + 5767168;
constexpr size_t WS_PRW = WS_PHG + 136314880;
constexpr size_t WS_A = WS_PRW + 119275520;
constexpr size_t WS_B = WS_A + 68157440;
constexpr size_t WS_MEMB = WS_B + 68157440;
constexpr size_t WS_KB = WS_MEMB + 4194304;
constexpr size_t WS_VT = WS_KB + 12582912;
constexpr size_t WS_RS0 = WS_VT + 12582912;
constexpr size_t WS_RSM = WS_RS0 + 133120;
constexpr size_t WS_KKN = WS_RSM + 8192;
constexpr size_t WS_SSQ1 = WS_KKN + 1064960;
constexpr size_t WS_SSQ2 = WS_SSQ1 + 2129920;
constexpr size_t WS_OI = WS_SSQ2 + 2129920;
constexpr size_t WS_DECB = WS_OI + 34078720;
constexpr size_t WS_BAR = WS_DECB + 1081344;
constexpr size_t WS_END = WS_BAR + 14080;
constexpr size_t HALF512 = 34078720;

struct Params {
    const float* in[35];
    float* out;
    unsigned char* ws;
    int lo, hi;
};

typedef __bf16 bf16x2_t __attribute__((ext_vector_type(2)));
__device__ __forceinline__ unsigned cvt_pk_bf16(float lo, float hi) { f32x2 f = {lo, hi}; bf16x2_t v = __builtin_convertvector(f, bf16x2_t); return __builtin_bit_cast(unsigned, v); }
__device__ __forceinline__ float bf_lo(unsigned w) { return __uint_as_float(w << 16); }
__device__ __forceinline__ float bf_hi(unsigned w) { return __uint_as_float(w & 0xffff0000u); }
__device__ __forceinline__ float bf1(bf16_t b) { return __uint_as_float(((unsigned)b) << 16); }
__device__ __forceinline__ bf16_t f2bf(float f) { return (bf16_t)(cvt_pk_bf16(f, 0.f) & 0xffffu); }
__device__ __forceinline__ float sigmoidf_(float x) { return __builtin_amdgcn_rcpf(1.0f + __expf(-x)); }
__device__ __forceinline__ void unpack8(const u32x4 w, float* f) {
    f[0] = bf_lo(w.x); f[1] = bf_hi(w.x); f[2] = bf_lo(w.y); f[3] = bf_hi(w.y); f[4] = bf_lo(w.z); f[5] = bf_hi(w.z); f[6] = bf_lo(w.w); f[7] = bf_hi(w.w);
}
__device__ __forceinline__ u32x4 pack8(const float* f) {
    u32x4 w; w.x = cvt_pk_bf16(f[0], f[1]); w.y = cvt_pk_bf16(f[2], f[3]); w.z = cvt_pk_bf16(f[4], f[5]); w.w = cvt_pk_bf16(f[6], f[7]); return w;
}
__device__ __forceinline__ int opaque_tid() { int t = threadIdx.x; asm volatile("" : "+v"(t)); return t; }
template <int CTRL> __device__ __forceinline__ float dppf(float x) {
    return __int_as_float(__builtin_amdgcn_update_dpp(0, __float_as_int(x), CTRL, 0xf, 0xf, true));
}
__device__ __forceinline__ float red4(float x) { x += dppf<0xB1>(x); x += dppf<0x4E>(x); return x; }
__device__ __forceinline__ float red8(float x) { x = red4(x); x += dppf<0x141>(x); return x; }
__device__ __forceinline__ float red16(float x) { x = red8(x); x += dppf<0x140>(x); return x; }
__device__ __forceinline__ float red64(float x) { x = red16(x); x += __shfl_xor(x, 16); x += __shfl_xor(x, 32); return x; }

namespace pg8 {
constexpr int BM = 256, BK = 64, HALF = 128, HTB = HALF * BK * 2, STAGE_BYTES = 8 * HTB, NXCD = 8, WGM = 8;
__device__ __forceinline__ int lds_byte(int r, int c) { const int st = (r >> 4) * 2 + (c >> 5), rr = r & 15, cc = c & 31, ob = rr * 64 + cc * 2; return st * 1024 + (ob ^ (((ob >> 9) & 1) << 5)); }
__device__ __forceinline__ void stage_rc(int b, int& R, int& C) { const int st = b / 1024, sb = b % 1024, swz = sb ^ (((sb >> 9) & 1) << 5); R = (st >> 1) * 16 + swz / 64; C = (st & 1) * 32 + (swz % 64) / 2; }
__device__ __forceinline__ int perm32(int rho) { const int n = rho >> 4, i = rho & 15; return 8 * (i >> 2) + 4 * n + (i & 3); }
struct Unit { int pm, pn; };
struct Gemm { const bf16_t* A; const bf16_t* Bt; int M, N, K; };
struct StaticOrder {
    int nM, nN, nwg, G, c, base, cap;
    __device__ __forceinline__ void init(int M, int N, int G_, int c_) { nM = M / BM; nN = N / BM; nwg = nM * nN; G = G_; c = c_; base = 0; cap = nwg; }
    __device__ __forceinline__ void window(int base_, int cap_) { base = base_; cap = cap_ < nwg ? cap_ : nwg; }
    __device__ bool next(int i, Unit& u) const {
        const long L = (long)base + (long)i * G + c; if (L >= cap) return false;
        int wgid = (int)L; { const int q = nwg / NXCD, r = nwg % NXCD, xcd = wgid % NXCD, off = wgid / NXCD; wgid = (xcd < r ? xcd * (q + 1) : r * (q + 1) + (xcd - r) * q) + off; }
        const int nig = WGM * nN, gid = wgid / nig, fm = gid * WGM, gsz = (nM - fm) < WGM ? (nM - fm) : WGM;
        u.pm = fm + ((wgid % nig) % gsz); u.pn = (wgid % nig) / gsz; return true;
    }
};
template <class Epi, bool ALIGN_EPI = true, bool SP2 = true>
__device__ __forceinline__ void gemm_phase(LAS unsigned char* lds, const Gemm g, const StaticOrder& S, const Epi& E) {
    const int tid = opaque_tid(), wid = __builtin_amdgcn_readfirstlane(tid >> 6), lane = tid & 63, wr = wid >> 2, wc = wid & 3, fr = lane & 15, fq = lane >> 4;
    const int K = g.K, nt = K / BK;
    unsigned voffA[2], voffB[2];
#pragma unroll
    for (int i = 0; i < 2; ++i) { int R, C; stage_rc(tid * 16 + i * 8192, R, C); const int Rb = Epi::PERM ? ((R & ~31) + perm32(R & 31)) : R;
        voffA[i] = (unsigned)(R * K + C) * 2u; voffB[i] = (unsigned)(Rb * K + C) * 2u; }
    const size_t kstep = (size_t)(BK * 2);
    const size_t hstep = (size_t)HALF * K * 2;
    const size_t tstep = 2 * hstep;
    const unsigned ldsw = (unsigned)wid * 1024u;
    const int aoff = lds_byte(wr * 64 + fr, fq * 8), boff = lds_byte(wc * 32 + fr, fq * 8);
#define PG8_SA(b, h) (((b) * 2 + (h)) * HTB)
#define PG8_SB(b, h) ((4 + (b) * 2 + (h)) * HTB)
#define PG8_STAGE(bufoff, gbase, voff) do { _Pragma("unroll") for (int _i = 0; _i < 2; ++_i) \
        __builtin_amdgcn_global_load_lds((const unsigned*)((const char*)(gbase) + (voff)[_i]), (LAS unsigned*)(lds + (bufoff) + ldsw + _i * 8192), 16, 0, 0); } while (0)
#define PG8_LDA(dst, b, h) do { _Pragma("unroll") for (int m = 0; m < 4; ++m) _Pragma("unroll") for (int k = 0; k < 2; ++k) dst[m][k] = *(const LAS bf16x8*)(lds + PG8_SA(b, h) + aoff + m * 2048 + k * 1024); } while (0)
#define PG8_LDB(dst, b, h) do { _Pragma("unroll") for (int n = 0; n < 2; ++n) _Pragma("unroll") for (int k = 0; k < 2; ++k) dst[n][k] = *(const LAS bf16x8*)(lds + PG8_SB(b, h) + boff + n * 2048 + k * 1024); } while (0)
#define PG8_MMA(ai, bj, At, Bt) do { __builtin_amdgcn_s_setprio(1); _Pragma("unroll") for (int m = 0; m < 4; ++m) _Pragma("unroll") for (int n = 0; n < 2; ++n) _Pragma("unroll") for (int k = 0; k < 2; ++k) \
        acc[ai][bj][m][n] = __builtin_amdgcn_mfma_f32_16x16x32_bf16(Bt[n][k], At[m][k], acc[ai][bj][m][n], 0, 0, 0); __builtin_amdgcn_s_setprio(0); } while (0)
#define PG8_WAIT_V(n) asm volatile("s_waitcnt vmcnt(" #n ")" ::: "memory")
#define PG8_WAIT_L(n) asm volatile("s_waitcnt lgkmcnt(" #n ")" ::: "memory")
#define PG8_BAR __builtin_amdgcn_s_barrier()
#define PG8_SCHED __builtin_amdgcn_sched_barrier(0)
    Unit cur, nxt; int ui = 0;
    if (!S.next(0, cur)) return;
    f32x4 acc[2][2][4][2];
#pragma unroll
    for (int a = 0; a < 2; ++a)
#pragma unroll
        for (int b = 0; b < 2; ++b)
#pragma unroll
            for (int m = 0; m < 4; ++m)
#pragma unroll
                for (int n = 0; n < 2; ++n) acc[a][b][m][n] = (f32x4){0.f, 0.f, 0.f, 0.f};
    bf16x8 At[4][2], B0[2][2], B1[2][2];
    const char* cA = (const char*)g.A + (size_t)cur.pm * tstep; const char* cB = (const char*)g.Bt + (size_t)cur.pn * tstep;
    if constexpr (SP2) {
        PG8_STAGE(PG8_SB(0, 0), cB, voffB); PG8_STAGE(PG8_SB(0, 1), cB + hstep, voffB); PG8_STAGE(PG8_SA(0, 0), cA, voffA); PG8_STAGE(PG8_SA(0, 1), cA + hstep, voffA);
        if (wr == 1) PG8_BAR;
        PG8_WAIT_V(2); PG8_BAR;
        PG8_STAGE(PG8_SB(1, 0), cB + kstep, voffB); PG8_STAGE(PG8_SA(1, 0), cA + kstep, voffA); PG8_STAGE(PG8_SB(1, 1), cB + hstep + kstep, voffB);
        PG8_WAIT_V(6); PG8_BAR;
    } else {
        PG8_STAGE(PG8_SB(0, 0), cB, voffB); PG8_STAGE(PG8_SA(0, 0), cA, voffA); PG8_STAGE(PG8_SB(0, 1), cB + hstep, voffB); PG8_STAGE(PG8_SA(0, 1), cA + hstep, voffA);
        if (wr == 1) PG8_BAR;
        PG8_WAIT_V(4); PG8_BAR;
        PG8_STAGE(PG8_SB(1, 0), cB + kstep, voffB); PG8_STAGE(PG8_SA(1, 0), cA + kstep, voffA); PG8_STAGE(PG8_SB(1, 1), cB + hstep + kstep, voffB);
        PG8_WAIT_V(6); PG8_BAR;
    }
    for (;;) {
        const bool has_next = S.next(ui + 1, nxt);
        const char* nA = has_next ? (const char*)g.A + (size_t)nxt.pm * tstep : cA; const char* nB = has_next ? (const char*)g.Bt + (size_t)nxt.pn * tstep : cB;
#pragma unroll 1
        for (int t = 0; t < nt; t += 2) {
            const bool last = (t == nt - 2);
            const char* a1 = cA + (size_t)(t + 1) * kstep;
            const char* a2 = last ? nA : cA + (size_t)(t + 2) * kstep; const char* b2 = last ? nB : cB + (size_t)(t + 2) * kstep;
            const char* a3 = a2 + kstep; const char* b3 = b2 + kstep;
            if constexpr (SP2) {
            PG8_LDB(B0, 0, 0); PG8_LDB(B1, 0, 1); PG8_SCHED; PG8_LDA(At, 0, 0); PG8_STAGE(PG8_SA(1, 1), a1 + hstep, voffA);
            PG8_WAIT_V(8); PG8_WAIT_L(0); PG8_BAR; PG8_MMA(0, 0, At, B0); PG8_MMA(0, 1, At, B1); PG8_BAR; PG8_SCHED;
            PG8_LDA(At, 0, 1); PG8_STAGE(PG8_SB(0, 0), b2, voffB); PG8_STAGE(PG8_SB(0, 1), b2 + hstep, voffB); PG8_STAGE(PG8_SA(0, 0), a2, voffA);
            PG8_WAIT_V(8); PG8_WAIT_L(0); PG8_BAR; PG8_MMA(1, 0, At, B0); PG8_MMA(1, 1, At, B1); PG8_BAR; PG8_SCHED;
            PG8_LDB(B0, 1, 0); PG8_LDB(B1, 1, 1); PG8_SCHED; PG8_LDA(At, 1, 0); PG8_STAGE(PG8_SA(0, 1), a2 + hstep, voffA);
            PG8_WAIT_V(8); PG8_WAIT_L(0); PG8_BAR; PG8_MMA(0, 0, At, B0); PG8_MMA(0, 1, At, B1); PG8_BAR; PG8_SCHED;
            PG8_LDA(At, 1, 1); PG8_STAGE(PG8_SB(1, 0), b3, voffB); PG8_STAGE(PG8_SB(1, 1), b3 + hstep, voffB); PG8_STAGE(PG8_SA(1, 0), a3, voffA);
            PG8_WAIT_V(8); PG8_WAIT_L(0); PG8_BAR; PG8_MMA(1, 0, At, B0); PG8_MMA(1, 1, At, B1); PG8_BAR; PG8_SCHED;
            } else {
            PG8_LDB(B0, 0, 0); PG8_SCHED; PG8_LDA(At, 0, 0); PG8_STAGE(PG8_SA(1, 1), a1 + hstep, voffA);
            PG8_WAIT_L(8); PG8_BAR; PG8_WAIT_L(0); PG8_MMA(0, 0, At, B0); PG8_BAR; PG8_SCHED;
            PG8_LDB(B1, 0, 1); PG8_STAGE(PG8_SB(0, 0), b2, voffB);
            PG8_BAR; PG8_WAIT_L(0); PG8_MMA(0, 1, At, B1); PG8_BAR;
            PG8_LDA(At, 0, 1); PG8_STAGE(PG8_SA(0, 0), a2, voffA);
            PG8_BAR; PG8_WAIT_L(0); PG8_MMA(1, 0, At, B0); PG8_BAR; PG8_SCHED;
            PG8_STAGE(PG8_SB(0, 1), b2 + hstep, voffB);
            PG8_WAIT_V(6); PG8_BAR; PG8_MMA(1, 1, At, B1); PG8_BAR;
            PG8_LDB(B0, 1, 0); PG8_SCHED; PG8_LDA(At, 1, 0); PG8_STAGE(PG8_SA(0, 1), a2 + hstep, voffA);
            PG8_WAIT_L(8); PG8_BAR; PG8_WAIT_L(0); PG8_MMA(0, 0, At, B0); PG8_BAR; PG8_SCHED;
            PG8_LDB(B1, 1, 1); PG8_STAGE(PG8_SB(1, 0), b3, voffB);
            PG8_BAR; PG8_WAIT_L(0); PG8_MMA(0, 1, At, B1); PG8_BAR;
            PG8_LDA(At, 1, 1); PG8_STAGE(PG8_SA(1, 0), a3, voffA);
            PG8_BAR; PG8_WAIT_L(0); PG8_MMA(1, 0, At, B0); PG8_BAR; PG8_SCHED;
            PG8_STAGE(PG8_SB(1, 1), b3 + hstep, voffB);
            PG8_WAIT_V(6); PG8_BAR; PG8_MMA(1, 1, At, B1); PG8_BAR;
            }
        }
        if constexpr (ALIGN_EPI) { if (wr == 0) PG8_BAR; }
        E(acc, cur, wr, wc, fr, fq);
        if (!has_next) break;
#pragma unroll
        for (int a = 0; a < 2; ++a)
#pragma unroll
            for (int b = 0; b < 2; ++b)
#pragma unroll
                for (int m = 0; m < 4; ++m)
#pragma unroll
                    for (int n = 0; n < 2; ++n) acc[a][b][m][n] = (f32x4){0.f, 0.f, 0.f, 0.f};
        cur = nxt; cA = nA; cB = nB; ++ui;
        if constexpr (ALIGN_EPI) { if (wr == 1) PG8_BAR; }
    }
    PG8_WAIT_V(0);
    if constexpr (!ALIGN_EPI) { if (wr == 0) PG8_BAR; }
    PG8_BAR;
#undef PG8_SA
#undef PG8_SB
#undef PG8_STAGE
#undef PG8_LDA
#undef PG8_LDB
#undef PG8_MMA
#undef PG8_WAIT_V
#undef PG8_WAIT_L
#undef PG8_BAR
#undef PG8_SCHED
}
}
using pg8::Unit;

__device__ __forceinline__ u32x4 pack_acc8(const f32x4 a, const f32x4 b, float s) {
    u32x4 w; w.x = cvt_pk_bf16(a[0] * s, a[1] * s); w.y = cvt_pk_bf16(a[2] * s, a[3] * s); w.z = cvt_pk_bf16(b[0] * s, b[1] * s); w.w = cvt_pk_bf16(b[2] * s, b[3] * s); return w;
}
__device__ __forceinline__ float rs_from_parts(const float* sp) {
    const f32x4 a = *(const f32x4*)sp, b = *(const f32x4*)(sp + 4), c = *(const f32x4*)(sp + 8), d = *(const f32x4*)(sp + 12);
    const float s = ((a[0] + a[1]) + (a[2] + a[3])) + ((b[0] + b[1]) + (b[2] + b[3])) + ((c[0] + c[1]) + (c[2] + c[3])) + ((d[0] + d[1]) + (d[2] + d[3]));
    return rsqrtf(s * (1.0f / 1024.0f) + 1e-6f);
}

__device__ __forceinline__ float rs_from_parts4(const float* sp, int fq) {
    const f32x4 a = *(const f32x4*)(sp + fq * 4); float s = (a[0] + a[1]) + (a[2] + a[3]);
    s += __shfl_xor(s, 16); s += __shfl_xor(s, 32);
    return rsqrtf(s * (1.0f / 1024.0f) + 1e-6f);
}
struct EpiWin {
    static constexpr bool PERM = true;
    bf16_t* phg; bf16_t* prw; const float* rs0; float* psh; float* ssh;
    __device__ __forceinline__ void operator()(const f32x4 (&acc)[2][2][4][2], const Unit& u, int wr, int wc, int fr, int fq) const {
        const int row0 = u.pm * 256 + wr * 64 + fr;
        const bool hg = u.pn < 8; bf16_t* base = hg ? phg : prw; const int ld = hg ? HGC : RWC; const int col0 = (hg ? u.pn : u.pn - 8) * 256 + wc * 32 + 8 * fq;
        float sv[8];
#pragma unroll
        for (int i = 0; i < 8; ++i) sv[i] = rs0[row0 + (i >> 2) * 128 + (i & 3) * 16];
#pragma unroll
        for (int ai = 0; ai < 2; ++ai)
#pragma unroll
            for (int m = 0; m < 4; ++m) {
                const int row = row0 + ai * 128 + m * 16; const float s = sv[ai * 4 + m]; bf16_t* rowp = base + (size_t)row * ld + col0;
#pragma unroll
                for (int bj = 0; bj < 2; ++bj) *(u32x4*)(rowp + bj * 128) = pack_acc8(acc[ai][bj][m][0], acc[ai][bj][m][1], s);
                if (!hg) {
                    bool last; float* dst;
                    if (row < NTOKP) { last = (row & 4095) == 4095; dst = psh + (row >> 12) * RWC; } else { const int rr = row - NTOKP; last = (rr & 31) == 31; dst = ssh + (rr >> 5) * RWC; }
                    if (last) {
#pragma unroll
                        for (int bj = 0; bj < 2; ++bj) { *(f32x4*)(dst + col0 + bj * 128) = acc[ai][bj][m][0] * s; *(f32x4*)(dst + col0 + bj * 128 + 4) = acc[ai][bj][m][1] * s; }
                    }
                }
            }
    }
};
struct EpiMemKV {
    static constexpr bool PERM = false;
    float* pmk; float* pmv; const float* rsm;
    __device__ __forceinline__ void operator()(const f32x4 (&acc)[2][2][4][2], const Unit& u, int wr, int wc, int fr, int fq) const {
        const int row0 = u.pm * 256 + wr * 64 + fr; const bool isk = u.pn < 4; float* base = isk ? pmk : pmv; const int col0 = (isk ? u.pn : u.pn - 4) * 256 + wc * 32 + 4 * fq;
        float sv[8];
#pragma unroll
        for (int i = 0; i < 8; ++i) sv[i] = rsm[row0 + (i >> 2) * 128 + (i & 3) * 16];
#pragma unroll
        for (int ai = 0; ai < 2; ++ai)
#pragma unroll
            for (int m = 0; m < 4; ++m) {
                const int row = row0 + ai * 128 + m * 16; const float s = sv[ai * 4 + m]; float* rowp = base + (size_t)row * D + col0;
#pragma unroll
                for (int bj = 0; bj < 2; ++bj)
#pragma unroll
                    for (int n = 0; n < 2; ++n) *(f32x4*)(rowp + bj * 128 + n * 16) = acc[ai][bj][m][n] * s;
            }
    }
};
struct EpiLora {
    static constexpr bool PERM = true;
    float* decay; bf16_t* kk; bf16_t* kka; bf16_t* kp; bf16_t* g; const bf16_t* xk; const float* kkn; const float* w0; const float* a0; const float* k_k; const float* k_a;
    __device__ __forceinline__ void operator()(const f32x4 (&acc)[2][2][4][2], const Unit& u, int wr, int wc, int fr, int fq) const {
        const int row0 = u.pm * 256 + wr * 64 + fr; const int type = u.pn >> 1; const int cb = (u.pn & 1) * 256 + wc * 32 + 8 * fq;
        if (type == 0) {
            float wv[2][8];
#pragma unroll
            for (int bj = 0; bj < 2; ++bj)
#pragma unroll
                for (int j = 0; j < 8; ++j) wv[bj][j] = w0[cb + bj * 128 + j];
#pragma unroll
            for (int ai = 0; ai < 2; ++ai)
#pragma unroll
                for (int m = 0; m < 4; ++m) {
                    const int row = row0 + ai * 128 + m * 16;
#pragma unroll
                    for (int bj = 0; bj < 2; ++bj) {
                        const size_t o = (size_t)row * 512 + cb + bj * 128; float d[8];
#pragma unroll
                        for (int j = 0; j < 8; ++j) { const float v = j < 4 ? acc[ai][bj][m][0][j] : acc[ai][bj][m][1][j - 4]; d[j] = __expf(-0.60653066f * sigmoidf_(wv[bj][j] + v)); }
                        *(f32x4*)(decay + o) = (f32x4){d[0], d[1], d[2], d[3]}; *(f32x4*)(decay + o + 4) = (f32x4){d[4], d[5], d[6], d[7]};
                    }
                }
        } else if (type == 1) {
#pragma unroll
            for (int ai = 0; ai < 2; ++ai)
#pragma unroll
                for (int mh = 0; mh < 2; ++mh) {
                    u32x4 xw[2][2]; float nr[2][2];
#pragma unroll
                    for (int m2 = 0; m2 < 2; ++m2) { const int row = row0 + ai * 128 + (mh * 2 + m2) * 16;
#pragma unroll
                        for (int bj = 0; bj < 2; ++bj) { xw[m2][bj] = *(const u32x4*)(xk + (size_t)row * 512 + cb + bj * 128); nr[m2][bj] = kkn[row * 8 + ((cb + bj * 128) >> 6)]; } }
#pragma unroll
                    for (int m2 = 0; m2 < 2; ++m2) { const int m = mh * 2 + m2; const int row = row0 + ai * 128 + m * 16;
#pragma unroll
                        for (int bj = 0; bj < 2; ++bj) {
                            const int c = cb + bj * 128; const size_t o = (size_t)row * 512 + c; float x[8], k1[8], k2[8], k3[8]; unpack8(xw[m2][bj], x);
#pragma unroll
                            for (int j = 0; j < 8; ++j) { const float v = j < 4 ? acc[ai][bj][m][0][j] : acc[ai][bj][m][1][j - 4]; const float a = sigmoidf_(a0[c + j] + v); const float kq = x[j] * k_k[c + j] * nr[m2][bj]; k1[j] = kq; k2[j] = kq * a; k3[j] = x[j] * (1.0f + (a - 1.0f) * k_a[c + j]); }
                            *(u32x4*)(kk + o) = pack8(k1); *(u32x4*)(kka + o) = pack8(k2); *(u32x4*)(kp + o) = pack8(k3);
                        } }
                }
        } else {
#pragma unroll
            for (int ai = 0; ai < 2; ++ai)
#pragma unroll
                for (int m = 0; m < 4; ++m) {
                    const int row = row0 + ai * 128 + m * 16;
#pragma unroll
                    for (int bj = 0; bj < 2; ++bj) *(u32x4*)(g + (size_t)row * 512 + cb + bj * 128) = pack_acc8(acc[ai][bj][m][0], acc[ai][bj][m][1], 1.0f);
                }
        }
    }
};
struct EpiRes {
    static constexpr bool PERM = false;
    const float* rp; const float* rs; float* out; bf16_t* xb; float* ssq;
    __device__ __forceinline__ void operator()(const f32x4 (&acc)[2][2][4][2], const Unit& u, int wr, int wc, int fr, int fq) const {
        const int row0 = u.pm * 256 + wr * 64 + fr; const int col0 = u.pn * 256 + wc * 32 + 4 * fq;
#pragma unroll
        for (int ai = 0; ai < 2; ++ai) {
            f32x4 rr[4][2][2];
#pragma unroll
            for (int m = 0; m < 4; ++m) {
                const int row = row0 + ai * 128 + m * 16;
                const float* rrow = (row < NTOKP ? rp + (size_t)row * D : rs + (size_t)(row - NTOKP) * D) + col0;
#pragma unroll
                for (int bj = 0; bj < 2; ++bj)
#pragma unroll
                    for (int n = 0; n < 2; ++n) rr[m][bj][n] = *(const f32x4*)(rrow + bj * 128 + n * 16);
            }
#pragma unroll
            for (int m = 0; m < 4; ++m) {
                const int row = row0 + ai * 128 + m * 16; float* orow = out + (size_t)row * D + col0; float ss = 0.f;
#pragma unroll
                for (int bj = 0; bj < 2; ++bj)
#pragma unroll
                    for (int n = 0; n < 2; ++n) {
                        const f32x4 x = rr[m][bj][n] + acc[ai][bj][m][n];
                        *(f32x4*)(orow + bj * 128 + n * 16) = x; ss += (x[0] * x[0] + x[1] * x[1]) + (x[2] * x[2] + x[3] * x[3]);
                        if (xb) { u32x2 w; w.x = cvt_pk_bf16(x[0], x[1]); w.y = cvt_pk_bf16(x[2], x[3]); *(u32x2*)(xb + (size_t)row * D + col0 + bj * 128 + n * 16) = w; }
                    }
                if (ssq) { ss += __shfl_xor(ss, 16); ss += __shfl_xor(ss, 32); if (fq == 0) ssq[row * 16 + u.pn * 4 + wc] = ss; }
            }
        }
    }
};
struct EpiQ {
    static constexpr bool PERM = true;
    bf16_t* q; const float* ssq;
    __device__ __forceinline__ void operator()(const f32x4 (&acc)[2][2][4][2], const Unit& u, int wr, int wc, int fr, int fq) const {
        const int row0 = u.pm * 256 + wr * 64 + fr; const int col0 = u.pn * 256 + wc * 32 + 8 * fq;
        float sv[8];
#pragma unroll
        for (int i = 0; i < 8; ++i) sv[i] = rs_from_parts4(ssq + (size_t)(row0 + (i >> 2) * 128 + (i & 3) * 16) * 16, fq) * 0.0625f;
#pragma unroll
        for (int ai = 0; ai < 2; ++ai)
#pragma unroll
            for (int m = 0; m < 4; ++m) {
                const int row = row0 + ai * 128 + m * 16; const float s = sv[ai * 4 + m]; bf16_t* rowp = q + (size_t)row * D + col0;
#pragma unroll
                for (int bj = 0; bj < 2; ++bj) *(u32x4*)(rowp + bj * 128) = pack_acc8(acc[ai][bj][m][0], acc[ai][bj][m][1], s);
            }
    }
};
struct EpiFF13 {
    static constexpr bool PERM = true;
    bf16_t* h; const float* ssq;
    __device__ __forceinline__ void operator()(const f32x4 (&acc)[2][2][4][2], const Unit& u, int wr, int wc, int fr, int fq) const {
        const int row0 = u.pm * 256 + wr * 64 + fr; const int col0 = u.pn * 128 + wc * 32 + 8 * fq;
        float sv[8];
#pragma unroll
        for (int i = 0; i < 8; ++i) sv[i] = rs_from_parts4(ssq + (size_t)(row0 + (i >> 2) * 128 + (i & 3) * 16) * 16, fq);
#pragma unroll
        for (int ai = 0; ai < 2; ++ai)
#pragma unroll
            for (int m = 0; m < 4; ++m) {
                const int row = row0 + ai * 128 + m * 16; const float s = sv[ai * 4 + m]; float o[8];
#pragma unroll
                for (int n = 0; n < 2; ++n)
#pragma unroll
                    for (int j = 0; j < 4; ++j) { const float a1 = acc[ai][0][m][n][j] * s, a3 = acc[ai][1][m][n][j] * s; o[n * 4 + j] = a1 * sigmoidf_(a1) * a3; }
                *(u32x4*)(h + (size_t)row * DFF + col0) = pack8(o);
            }
    }
};

template <int MODE>
__device__ __forceinline__ void sgemm_sample(LAS unsigned char* lds, const bf16_t* A, const bf16_t* Bt, int K, const float* resid, float* out, bf16_t* xb, float* ssq_out, const float* ssq_in) {
    const int tid = opaque_tid(), lane = tid & 63, w = __builtin_amdgcn_readfirstlane(tid >> 6), fr = lane & 15, fq = lane >> 4;
    const int u = blockIdx.x * 8 + w;
    const bool act = (gridDim.x == 256);
#pragma unroll 1
    for (int uu = u; uu < 2048; uu += gridDim.x * 8) {
        const int rt = uu >> 6, ct = uu & 63; const int row = NTOKP + rt * 16 + fr, col0 = ct * 16 + fq * 4;
        const bf16_t* ap = A + (size_t)row * K + fq * 8; const bf16_t* bp = Bt + (size_t)(ct * 16 + fr) * K + fq * 8;
        f32x4 acc = {0.f, 0.f, 0.f, 0.f};
#pragma unroll 8
        for (int ks = 0; ks < K / 32; ++ks) {
            const bf16x8 a = *(const bf16x8*)(ap + ks * 32); const bf16x8 b = *(const bf16x8*)(bp + ks * 32);
            acc = __builtin_amdgcn_mfma_f32_16x16x32_bf16(b, a, acc, 0, 0, 0);
        }
        if (MODE == 0) {
            const f32x4 x = *(const f32x4*)(resid + (size_t)(row - NTOKP) * D + col0) + acc;
            *(f32x4*)(out + (size_t)row * D + col0) = x;
            if (xb) { u32x2 wv; wv.x = cvt_pk_bf16(x[0], x[1]); wv.y = cvt_pk_bf16(x[2], x[3]); *(u32x2*)(xb + (size_t)row * D + col0) = wv; }
            if (ssq_out) {
                float ss = (x[0] * x[0] + x[1] * x[1]) + (x[2] * x[2] + x[3] * x[3]); ss += __shfl_xor(ss, 16); ss += __shfl_xor(ss, 32);
                if (fq == 0) *(LAS float*)(lds + (w * 16 + fr) * 4) = ss;
                __syncthreads();
                if (tid < 16) { float t = 0.f;
#pragma unroll
                    for (int i = 0; i < 8; ++i) t += *(const LAS float*)(lds + (i * 16 + tid) * 4);
                    const int g = (uu & 63) >> 3; float* sp = ssq_out + (size_t)(NTOKP + rt * 16 + tid) * 16; sp[g] = t; sp[8 + g] = 0.f; }
                __syncthreads();
            }
        } else {
            const float sc = rs_from_parts(ssq_in + (size_t)row * 16) * 0.0625f;
            u32x2 wv; wv.x = cvt_pk_bf16(acc[0] * sc, acc[1] * sc); wv.y = cvt_pk_bf16(acc[2] * sc, acc[3] * sc); *(u32x2*)(xb + (size_t)row * D + col0) = wv;
        }
    }
    (void)act;
    __syncthreads();
}

__device__ __forceinline__ void transpose_job(LAS float* tile, const float* src, int ldn, int K, int N, const float* gain, bf16_t* dst, int mode, int noff, int nbatch, size_t sstride, size_t dstride) {
    const int tid = opaque_tid(); const int tn = N / 64, tk = K / 64, per = tn * tk, total = per * nbatch;
    int t = blockIdx.x; if (t >= total) return;
    float v[8];
#define TR_LD(tt_) do { const int bb_ = (tt_) / per, t2_ = (tt_) % per; const int k0_ = (t2_ / tn) * 64, n0_ = (t2_ % tn) * 64; const float* s_ = src + (size_t)bb_ * sstride; \
        _Pragma("unroll") for (int i = 0; i < 8; ++i) { const int idx = tid + i * 512, kk = idx >> 6, nn = idx & 63; v[i] = s_[(size_t)(k0_ + kk) * ldn + n0_ + nn]; } \
        if (gain) { float g_[8]; _Pragma("unroll") for (int i = 0; i < 8; ++i) g_[i] = gain[k0_ + ((tid + i * 512) >> 6)]; _Pragma("unroll") for (int i = 0; i < 8; ++i) v[i] *= g_[i]; } } while (0)
    TR_LD(t);
#pragma unroll 1
    for (; t < total; t += gridDim.x) {
        const int bb = t / per, tt = t % per; const int k0 = (tt / tn) * 64, n0 = (tt % tn) * 64; bf16_t* d = dst + (size_t)bb * dstride;
#pragma unroll
        for (int i = 0; i < 8; ++i) { const int idx = tid + i * 512, kk = idx >> 6, nn = idx & 63; tile[kk * 65 + nn] = v[i]; }
        __syncthreads();
        if (t + (int)gridDim.x < total) TR_LD(t + (int)gridDim.x);
#pragma unroll
        for (int i = 0; i < 4; ++i) { const int idx = tid + i * 512, nn = idx >> 5, kp = idx & 31; const int n = n0 + nn;
            int r = n + noff; if (mode == 1) r = (n >> 7) * 256 + (n & 127); else if (mode == 2) r = (n >> 7) * 256 + 128 + (n & 127);
            *(unsigned*)(d + (size_t)r * K + k0 + 2 * kp) = cvt_pk_bf16(tile[(2 * kp) * 65 + nn], tile[(2 * kp + 1) * 65 + nn]); }
        __syncthreads();
    }
#undef TR_LD
}
__device__ __forceinline__ void transpose_wave(const float* src, int ldn, int K, int N, const float* gain, bf16_t* dst, int mode, int noff, int nbatch, size_t sstride, size_t dstride) {
    const int tid = opaque_tid(), lane = tid & 63, wid = tid >> 6; const int gw = blockIdx.x * 8 + wid, nw = gridDim.x * 8;
    const int tn = N / 64, tk = K / 64, per = tn * tk, total = per * nbatch;
#pragma unroll 1
    for (int t = gw; t < total; t += nw) {
        const int bb = t / per, tt = t - bb * per; const int k0 = (tt / tn) * 64, n0 = (tt % tn) * 64;
        const float* s_ = src + (size_t)bb * sstride + (size_t)k0 * ldn + n0 + lane; float v[64];
#pragma unroll
        for (int k = 0; k < 64; ++k) v[k] = s_[(size_t)k * ldn];
        if (gain) {
#pragma unroll
            for (int k = 0; k < 64; ++k) v[k] *= gain[k0 + k];
        }
        const int n = n0 + lane; int r = n + noff; if (mode == 1) r = (n >> 7) * 256 + (n & 127); else if (mode == 2) r = (n >> 7) * 256 + 128 + (n & 127);
        bf16_t* d = dst + (size_t)bb * dstride + (size_t)r * K + k0;
#pragma unroll
        for (int i = 0; i < 8; ++i) *(u32x4*)(d + i * 8) = pack8(v + i * 8);
    }
}
__device__ __forceinline__ void ph_prep(const Params& p, LAS unsigned char* lds) {
    const int tid = opaque_tid(), lane = tid & 63, wid = tid >> 6; const int gw = blockIdx.x * 8 + wid, nw = gridDim.x * 8;
    unsigned char* ws = p.ws;
    bf16_t* xb = (bf16_t*)(ws + WS_A); bf16_t* memb = (bf16_t*)(ws + WS_MEMB); float* rs0 = (float*)(ws + WS_RS0); float* rsm = (float*)(ws + WS_RSM);
    {
        const int TOT = NTOK + 2048; f32x4 cur[4], nxt[4];
#define RC_SRC(row) ((row) < NTOKP ? p.in[0] + (size_t)(row) * D : (row) < NTOK ? p.in[2] + (size_t)((row) - NTOKP) * D : p.in[1] + (size_t)((row) - NTOK) * D)
        int row = gw;
        if (row < TOT) { const f32x4* sp = (const f32x4*)RC_SRC(row);
#pragma unroll
            for (int i = 0; i < 4; ++i) cur[i] = sp[i * 64 + lane]; }
#pragma unroll 1
        for (; row < TOT; row += nw) {
            const int nr = row + nw;
            if (nr < TOT) { const f32x4* sp = (const f32x4*)RC_SRC(nr);
#pragma unroll
                for (int i = 0; i < 4; ++i) nxt[i] = sp[i * 64 + lane]; }
            float ss = 0.f;
#pragma unroll
            for (int i = 0; i < 4; ++i) ss += (cur[i][0] * cur[i][0] + cur[i][1] * cur[i][1]) + (cur[i][2] * cur[i][2] + cur[i][3] * cur[i][3]);
            ss = red64(ss);
            bf16_t* dstp = row < NTOK ? xb + (size_t)row * D : memb + (size_t)(row - NTOK) * D;
#pragma unroll
            for (int i = 0; i < 4; ++i) { u32x2 w2; w2.x = cvt_pk_bf16(cur[i][0], cur[i][1]); w2.y = cvt_pk_bf16(cur[i][2], cur[i][3]); ((u32x2*)dstp)[i * 64 + lane] = w2; }
            if (lane == 0) { if (row < NTOK) rs0[row] = rsqrtf(ss * (1.0f / 1024.0f) + 1e-6f); else rsm[row - NTOK] = rsqrtf(ss * (1.0f / 1024.0f) + 1e-6f); }
#pragma unroll
            for (int i = 0; i < 4; ++i) cur[i] = nxt[i];
        }
#undef RC_SRC
    }
    LAS float* tile = (LAS float*)lds;
#pragma unroll 1
    for (int job = 0; job < 9; ++job) {
        const float* src; const float* gain = nullptr; int ldn = 1024, K = 1024, N = 1024, mode = 0, noff = 0; size_t doff;
        switch (job) {
            case 0: src = p.in[10]; gain = p.in[9]; ldn = 3840; N = 3840; doff = WS_WIN; break;
            case 1: src = p.in[23]; doff = WS_WOUT; break;
            case 2: src = p.in[26]; gain = p.in[24]; doff = WS_WCQ; break;
            case 3: src = p.in[27]; gain = p.in[25]; doff = WS_WKV; break;
            case 4: src = p.in[28]; gain = p.in[25]; doff = WS_WKV; noff = 1024; break;
            case 5: src = p.in[29]; doff = WS_WCO; break;
            case 6: src = p.in[31]; gain = p.in[30]; ldn = 2816; N = 2816; mode = 1; doff = WS_WFF13; break;
            case 7: src = p.in[32]; gain = p.in[30]; ldn = 2816; N = 2816; mode = 2; doff = WS_WFF13; break;
            default: src = p.in[33]; K = 2816; doff = WS_WFF2; break;
        }
        transpose_job(tile, src, ldn, K, N, gain, (bf16_t*)(ws + doff), mode, noff, 1, 0, 0);
    }
    bf16_t* wl = (bf16_t*)(ws + WS_WLORA);
    for (int it = blockIdx.x * 512 + tid; it < 1536 * 32; it += gridDim.x * 512) {
        const int n = it % 1536, k0 = (it / 1536) * 8; const float* src = nullptr; int kb = 0, nn = n;
        if (n < 512) { if (k0 < 64) { src = p.in[14]; kb = k0; } }
        else if (n < 1024) { nn = n - 512; if (k0 >= 64 && k0 < 128) { src = p.in[16]; kb = k0 - 64; } }
        else { nn = n - 1024; if (k0 >= 128) { src = p.in[17]; kb = k0 - 128; } }
        float v[8];
#pragma unroll
        for (int j = 0; j < 8; ++j) v[j] = 0.f;
        if (src) {
#pragma unroll
            for (int j = 0; j < 8; ++j) v[j] = src[(kb + j) * 512 + nn];
        }
        *(u32x4*)(wl + (size_t)n * 256 + k0) = pack8(v);
    }
}

__device__ __forceinline__ void ph_rwprep(const Params& p) {
    const int tid = opaque_tid(), lane = tid & 63, wid = tid >> 6; const int gw = blockIdx.x * 8 + wid, nw = gridDim.x * 8;
    unsigned char* ws = p.ws;
    const bf16_t* prw = (const bf16_t*)(ws + WS_PRW);
    bf16_t* rb = (bf16_t*)(ws + WS_A); bf16_t* vb = (bf16_t*)(ws + WS_A + HALF512);
    bf16_t* al = (bf16_t*)(ws + WS_B); bf16_t* xk = (bf16_t*)(ws + WS_B + 17039360);
    float* kkn = (float*)(ws + WS_KKN);
    const float* mu = p.in[12]; const float* k_k = p.in[18];
    float mu8[3][8], mul[4], kk8[8];
#pragma unroll
    for (int i = 0; i < 3; ++i)
#pragma unroll
        for (int j = 0; j < 8; ++j) mu8[i][j] = mu[i * 512 + lane * 8 + j];
#pragma unroll
    for (int j = 0; j < 4; ++j) mul[j] = mu[1536 + lane * 4 + j];
#pragma unroll
    for (int j = 0; j < 8; ++j) kk8[j] = k_k[lane * 8 + j];
#pragma unroll 1
    for (int row = gw; row < NTOK; row += nw) {
        const float* sh = nullptr; bool first;
        if (row < NTOKP) first = (row & 4095) == 0; else { const int rr = row - NTOKP; first = (rr & 31) == 0; sh = p.in[7] + (size_t)(rr >> 5) * RWC; }
        const bf16_t* cur = prw + (size_t)row * RWC; const bf16_t* prv = first ? cur : cur - RWC;
        u32x4 cw[3], pw[3];
#pragma unroll
        for (int i = 0; i < 3; ++i) { cw[i] = *(const u32x4*)(cur + i * 512 + lane * 8); pw[i] = *(const u32x4*)(prv + i * 512 + lane * 8); }
        const u32x2 cl = *(const u32x2*)(cur + 1536 + lane * 4), pl = *(const u32x2*)(prv + 1536 + lane * 4);
        float pvf[3][8], plf[4];
#pragma unroll
        for (int i = 0; i < 3; ++i) unpack8(pw[i], pvf[i]);
        plf[0] = bf_lo(pl.x); plf[1] = bf_hi(pl.x); plf[2] = bf_lo(pl.y); plf[3] = bf_hi(pl.y);
        if (first) {
            if (sh) {
#pragma unroll
                for (int i = 0; i < 3; ++i) { const f32x4 a = *(const f32x4*)(sh + i * 512 + lane * 8), b2 = *(const f32x4*)(sh + i * 512 + lane * 8 + 4);
                    pvf[i][0] = a[0]; pvf[i][1] = a[1]; pvf[i][2] = a[2]; pvf[i][3] = a[3]; pvf[i][4] = b2[0]; pvf[i][5] = b2[1]; pvf[i][6] = b2[2]; pvf[i][7] = b2[3]; }
                const f32x4 a = *(const f32x4*)(sh + 1536 + lane * 4); plf[0] = a[0]; plf[1] = a[1]; plf[2] = a[2]; plf[3] = a[3];
            } else {
#pragma unroll
                for (int i = 0; i < 3; ++i)
#pragma unroll
                    for (int j = 0; j < 8; ++j) pvf[i][j] = 0.f;
                plf[0] = plf[1] = plf[2] = plf[3] = 0.f;
            }
        }
        const size_t o = (size_t)row * 512 + lane * 8;
#pragma unroll
        for (int i = 0; i < 3; ++i) {
            float c[8], x[8]; unpack8(cw[i], c);
#pragma unroll
            for (int j = 0; j < 8; ++j) x[j] = c[j] + (pvf[i][j] - c[j]) * mu8[i][j];
            if (i == 0) *(u32x4*)(rb + o) = pack8(x);
            else if (i == 2) *(u32x4*)(vb + o) = pack8(x);
            else {
                *(u32x4*)(xk + o) = pack8(x); float ss = 0.f;
#pragma unroll
                for (int j = 0; j < 8; ++j) { const float kv = x[j] * kk8[j]; ss += kv * kv; }
                ss = red8(ss);
                if ((lane & 7) == 0) kkn[row * 8 + (lane >> 3)] = 1.0f / fmaxf(sqrtf(ss), 1e-12f);
            }
        }
        {
            const float c[4] = {bf_lo(cl.x), bf_hi(cl.x), bf_lo(cl.y), bf_hi(cl.y)}; float x[4];
#pragma unroll
            for (int j = 0; j < 4; ++j) { float t = c[j] + (plf[j] - c[j]) * mul[j]; if (lane < 16) t = 1.0f - 2.0f * __builtin_amdgcn_rcpf(__expf(2.0f * t) + 1.0f); else if (lane >= 32) t = sigmoidf_(t); x[j] = t; }
            u32x2 w; w.x = cvt_pk_bf16(x[0], x[1]); w.y = cvt_pk_bf16(x[2], x[3]); *(u32x2*)(al + (size_t)row * 256 + lane * 4) = w;
        }
    }
}
__device__ __forceinline__ void ph_kvconv(const Params& p, LAS unsigned char* lds) {
    const int tid = opaque_tid(); unsigned char* ws = p.ws; bf16_t* kb = (bf16_t*)(ws + WS_KB); bf16_t* vt = (bf16_t*)(ws + WS_VT);
    const size_t per = 256 * 1024;
    {
        const size_t nvec = 24 * per / 4, stride = (size_t)gridDim.x * 512;
        for (size_t i0 = (size_t)blockIdx.x * 512 + tid; i0 < nvec; i0 += 4 * stride) {
            f32x4 v[4];
#pragma unroll
            for (int j = 0; j < 4; ++j) { const size_t i = i0 + j * stride; if (i < nvec) { const size_t e = i * 4; const int b = (int)(e / per); const size_t off = e % per;
                const float* src = b < 8 ? p.out + O_PMK + (size_t)b * per + off : p.in[3] + (size_t)(b - 8) * per + off; v[j] = *(const f32x4*)src; } }
#pragma unroll
            for (int j = 0; j < 4; ++j) { const size_t i = i0 + j * stride; if (i < nvec) { u32x2 w; w.x = cvt_pk_bf16(v[j][0], v[j][1]); w.y = cvt_pk_bf16(v[j][2], v[j][3]); *(u32x2*)(kb + i * 4) = w; } }
        }
    }
    LAS float* tile = (LAS float*)lds;
#pragma unroll 1
    for (int job = 0; job < 2; ++job) {
        const float* src = job ? p.in[4] : p.out + O_PMV; bf16_t* dst = job ? vt + 8 * per : vt; const int nb = job ? 16 : 8;
        transpose_job(tile, src, 1024, 256, 1024, nullptr, dst, 0, 0, nb, per, per);
    }
}

struct RwStep { f32x4 d, k, a, p, r; float v; };
__device__ __forceinline__ void rwkv_scan(const Params& p, LAS unsigned char* lds, int rowbase, int T, int h, int q4, const float* S0, float* Sout) {
    const int tid = opaque_tid(), lane = tid & 63, w = __builtin_amdgcn_readfirstlane(tid >> 6), rowl = lane >> 4, seg = lane & 15; const int vloc = (w & 3) * 4 + rowl, vrow = q4 * 16 + vloc;
    unsigned char* ws = p.ws;
    const float* decay = p.out; const bf16_t* kk = (const bf16_t*)((const unsigned char*)p.out + 68157440); const bf16_t* kka = (const bf16_t*)((const unsigned char*)p.out + 68157440 + HALF512);
    const bf16_t* kp = (const bf16_t*)(ws + WS_PRW); const bf16_t* rb = (const bf16_t*)(ws + WS_A); const bf16_t* vb = (const bf16_t*)(ws + WS_A + HALF512);
    bf16_t* ob = (bf16_t*)(ws + WS_B);
    const bool comp = w < 4;
    f32x4 S = (f32x4){0.f, 0.f, 0.f, 0.f};
    if (comp && S0) S = *(const f32x4*)(S0 + vrow * 64 + seg * 4);
    constexpr int BUF = 43008;
    const int lstep = tid >> 4, lj = tid & 15;
    f32x4 gd; u32x2 gk, ga, gp, gr, gv;
    auto gload = [&](int c) {
        const size_t o = (size_t)(rowbase + c * 32 + lstep) * 512 + h * 64 + lj * 4;
        gd = *(const f32x4*)(decay + o); gk = *(const u32x2*)(kk + o); ga = *(const u32x2*)(kka + o); gp = *(const u32x2*)(kp + o); gr = *(const u32x2*)(rb + o);
        if (lj < 4) gv = *(const u32x2*)(vb + (size_t)(rowbase + c * 32 + lstep) * 512 + h * 64 + q4 * 16 + lj * 4);
    };
    auto up4 = [](const u32x2 x) { return (f32x4){bf_lo(x.x), bf_hi(x.x), bf_lo(x.y), bf_hi(x.y)}; };
    const int nch = T / 32;
    gload(0);
#pragma unroll 1
    for (int c = 0; c < nch; ++c) {
        LAS unsigned char* b = lds + (c & 1) * BUF;
        *(LAS f32x4*)(b + lstep * 256 + lj * 16) = gd;
        *(LAS f32x4*)(b + 8192 + lstep * 256 + lj * 16) = up4(gk);
        *(LAS f32x4*)(b + 16384 + lstep * 256 + lj * 16) = up4(ga);
        *(LAS f32x4*)(b + 24576 + lstep * 256 + lj * 16) = up4(gp);
        *(LAS f32x4*)(b + 32768 + lstep * 256 + lj * 16) = up4(gr);
        if (lj < 4) *(LAS f32x4*)(b + 40960 + lstep * 64 + lj * 16) = up4(gv);
        __syncthreads();
        if (c + 1 < nch) gload(c + 1);
        if (comp) {
            const LAS unsigned char* bs = b + seg * 16; const LAS unsigned char* bv = b + 40960 + vloc * 4;
#define RW_LD(X, s) do { X.d = *(const LAS f32x4*)(bs + (s) * 256); X.k = *(const LAS f32x4*)(bs + 8192 + (s) * 256); X.a = *(const LAS f32x4*)(bs + 16384 + (s) * 256); \
                         X.p = *(const LAS f32x4*)(bs + 24576 + (s) * 256); X.r = *(const LAS f32x4*)(bs + 32768 + (s) * 256); X.v = *(const LAS float*)(bv + (s) * 64); } while (0)
#define RW_STEP(X, s) do { const f32x4 pr = S * X.k; const f32x4 T = S * X.d + X.v * X.p; float sa = (pr[0] + pr[1]) + (pr[2] + pr[3]); sa = -red16(sa); \
                           S = T + sa * X.a; const f32x4 py = S * X.r; float y = (py[0] + py[1]) + (py[2] + py[3]); y = red16(y); \
                           yk = (seg == ((s) & 15)) ? y : yk; } while (0)
            RwStep xa, xb, xc; float yk = 0.f;
#define RW_YST(s) do { if ((s) == 15) ob[(size_t)(rowbase + c * 32 + seg) * D + 512 + h * 64 + vrow] = f2bf(yk); } while (0)
            RW_LD(xa, 0); RW_LD(xb, 1);
#pragma unroll
            for (int s = 0; s < 30; s += 3) {
                RW_LD(xc, s + 2); RW_STEP(xa, s); RW_YST(s);
                RW_LD(xa, s + 3); RW_STEP(xb, s + 1); RW_YST(s + 1);
                RW_LD(xb, s + 4); RW_STEP(xc, s + 2); RW_YST(s + 2);
            }
            RW_STEP(xa, 30); RW_STEP(xb, 31);
            ob[(size_t)(rowbase + c * 32 + 16 + seg) * D + 512 + h * 64 + vrow] = f2bf(yk);
#undef RW_YST
#undef RW_LD
#undef RW_STEP
        }
    }
    if (comp) *(f32x4*)(Sout + vrow * 64 + seg * 4) = S;
    __syncthreads();
}

__device__ __forceinline__ void hg_prep_chunk(const Params& p, LAS unsigned char* lds, int task) {
    const int tid = opaque_tid(), lane = tid & 63, w = __builtin_amdgcn_readfirstlane(tid >> 6), fr = lane & 15, fq = lane >> 4;
    unsigned char* ws = p.ws; bf16_t* phg = (bf16_t*)(ws + WS_PHG); bf16_t* oi = (bf16_t*)(ws + WS_OI); float* decb = (float*)(ws + WS_DECB);
    constexpr int QG = 0, KG = 17408, VT = 34816, ATT = 53248, SEG = 62464;
    int row0, TC, h;
    if (task < 2048) { const int seq = task >> 6, ch = task & 63; h = seq & 3; row0 = (seq >> 2) * 4096 + ch * 64; TC = 64; }
    else { const int s = task - 2048; h = s & 3; row0 = NTOKP + (s >> 2) * 32; TC = 32; }
    const int c = tid & 127, sg = tid >> 7;
    const float l0 = p.in[8][h * 128 + c], l1 = p.in[8][512 + h * 128 + c]; const float lb = 1.0f / (1.0f + __expf(l1 - l0)), omlb = 1.0f - lb;
    const bool valid = sg * 16 < TC;
    float cp[16], kx[16], qv[16], vv[16]; float run = 1.f;
    {
        const bf16_t* rp = phg + (size_t)(row0 + (valid ? sg * 16 : 0)) * HGC + h * 128 + c; bf16_t rq[16], rf[16], rv[16];
#pragma unroll
        for (int j = 0; j < 16; ++j) { rq[j] = rp[(size_t)j * HGC]; rf[j] = rp[(size_t)j * HGC + 512]; rv[j] = rp[(size_t)j * HGC + 1024]; }
#pragma unroll
        for (int j = 0; j < 16; ++j) {
            const float sgm = sigmoidf_(bf1(rf[j])); const float f = valid ? lb + omlb * sgm : 1.0f; run *= f; cp[j] = run;
            kx[j] = valid ? omlb * (1.0f - sgm) : 0.f; qv[j] = valid ? bf1(rq[j]) : 0.f; vv[j] = valid ? bf1(rv[j]) : 0.f;
        }
    }
    *(LAS float*)(lds + SEG + (sg * 128 + c) * 4) = run;
    __syncthreads();
    float pre = 1.f, tot = 1.f;
#pragma unroll
    for (int s2 = 0; s2 < 4; ++s2) { const float x = *(const LAS float*)(lds + SEG + (s2 * 128 + c) * 4); tot *= x; if (s2 < sg) pre *= x; }
    {
        float kd[16];
#pragma unroll
        for (int j = 0; j < 16; ++j) {
            const float P = pre * cp[j]; const int t = sg * 16 + j; const float qg = qv[j] * P, kg = kx[j] * __builtin_amdgcn_rcpf(P);
            const bf16_t qgb = f2bf(qg);
            *(LAS bf16_t*)(lds + QG + t * 272 + c * 2) = qgb;
            *(LAS bf16_t*)(lds + KG + t * 272 + c * 2) = f2bf(kg);
            kd[j] = kg * tot;
            if (valid) phg[(size_t)(row0 + t) * HGC + h * 128 + c] = qgb;
        }
        const u32x4 v0 = pack8(vv), v1 = pack8(vv + 8);
        *(LAS u32x4*)(lds + VT + c * 144 + sg * 32) = v0; *(LAS u32x4*)(lds + VT + c * 144 + sg * 32 + 16) = v1;
        if (valid) {
            const int lin = c * TC + sg * 16; bf16_t* dst = phg + (size_t)(row0 + (lin >> 7)) * HGC + h * 128 + (lin & 127);
            *(u32x4*)(dst + 512) = pack8(kd); *(u32x4*)(dst + 512 + 8) = pack8(kd + 8);
            *(u32x4*)(dst + 1024) = v0; *(u32x4*)(dst + 1024 + 8) = v1;
        }
        if (sg == 0) decb[task * 128 + c] = tot;
    }
    __syncthreads();
    {
        const int tt = w >> 1;
#pragma unroll
        for (int q2 = 0; q2 < 2; ++q2) {
            const int st = 2 * (w & 1) + q2; f32x4 a = {0.f, 0.f, 0.f, 0.f};
#pragma unroll
            for (int ks = 0; ks < 4; ++ks) {
                const bf16x8 kf = *(const LAS bf16x8*)(lds + KG + (st * 16 + fr) * 272 + (ks * 32 + fq * 8) * 2);
                const bf16x8 qf = *(const LAS bf16x8*)(lds + QG + (tt * 16 + fr) * 272 + (ks * 32 + fq * 8) * 2);
                a = __builtin_amdgcn_mfma_f32_16x16x32_bf16(kf, qf, a, 0, 0, 0);
            }
            const int t = tt * 16 + fr; float m[4];
#pragma unroll
            for (int j = 0; j < 4; ++j) { const int s = st * 16 + fq * 4 + j; m[j] = (s <= t) ? a[j] : 0.f; }
            u32x2 wv; wv.x = cvt_pk_bf16(m[0], m[1]); wv.y = cvt_pk_bf16(m[2], m[3]);
            *(LAS u32x2*)(lds + ATT + t * 144 + (st * 16 + fq * 4) * 2) = wv;
        }
    }
    __syncthreads();
#pragma unroll
    for (int tt = 0; tt < 4; ++tt) {
        f32x4 a = {0.f, 0.f, 0.f, 0.f};
#pragma unroll
        for (int ks = 0; ks < 2; ++ks) {
            const bf16x8 vf = *(const LAS bf16x8*)(lds + VT + (w * 16 + fr) * 144 + (ks * 32 + fq * 8) * 2);
            const bf16x8 af = *(const LAS bf16x8*)(lds + ATT + (tt * 16 + fr) * 144 + (ks * 32 + fq * 8) * 2);
            a = __builtin_amdgcn_mfma_f32_16x16x32_bf16(vf, af, a, 0, 0, 0);
        }
        const int t = tt * 16 + fr;
        if (t < TC) { u32x2 wv; wv.x = cvt_pk_bf16(a[0], a[1]); wv.y = cvt_pk_bf16(a[2], a[3]); *(u32x2*)(oi + ((size_t)(h * 4 + (w >> 1)) * NTOK + row0 + t) * 32 + (w & 1) * 16 + fq * 4) = wv; }
    }
    __syncthreads();
}
__device__ __forceinline__ void ph_hgprep(const Params& p, LAS unsigned char* lds) {
#pragma unroll 1
    for (int t = blockIdx.x; t < 2112; t += gridDim.x) hg_prep_chunk(p, lds, t);
}
__device__ __forceinline__ void hg_seq(const Params& p, LAS unsigned char* lds, int task) {
    const int tid = opaque_tid(), lane = tid & 63, w = __builtin_amdgcn_readfirstlane(tid >> 6), fr = lane & 15, fq = lane >> 4;
    unsigned char* ws = p.ws; const bf16_t* phg = (const bf16_t*)(ws + WS_PHG); const bf16_t* oi = (const bf16_t*)(ws + WS_OI); const float* decb = (const float*)(ws + WS_DECB); bf16_t* ob = (bf16_t*)(ws + WS_B);
    constexpr int QG = 0, KDT = 17408, VT = 35840, ST = 40448;
    int rowbase, TC, h, vq, nch, dbase; const float* S0 = nullptr; float* Sout;
    if (task < 128) { const int b = task >> 4; h = (task >> 2) & 3; vq = task & 3; rowbase = b * 4096; TC = 64; nch = 64; dbase = (b * 4 + h) * 64; Sout = p.out + O_PHG + (size_t)(b * 4 + h) * 16384; }
    else { const int s = task - 128, b = s >> 4; h = (s >> 2) & 3; vq = s & 3; rowbase = NTOKP + b * 32; TC = 32; nch = 1; dbase = 2048 + b * 4 + h; S0 = p.in[5] + (size_t)(b * 4 + h) * 16384; Sout = p.out + O_SHG + (size_t)(b * 4 + h) * 16384; }
    f32x4 S[2];
#pragma unroll
    for (int vt = 0; vt < 2; ++vt)
#pragma unroll
        for (int j = 0; j < 4; ++j) S[vt][j] = S0 ? S0[(w * 16 + fq * 4 + j) * 128 + vq * 32 + vt * 16 + fr] : 0.f;
    const int tt = w >> 1, vt_o = w & 1;
    const int prow = tid >> 4, pcol = tid & 15;
    struct HgR { u32x4 gq[2], gk[2], gv; u32x2 go; f32x4 gdec; };
    auto gload = [&](HgR& R, int ch) {
        const int row0 = rowbase + ch * 64;
#pragma unroll
        for (int j = 0; j < 2; ++j) {
            const int r = prow + j * 32; const bool ok = r < TC;
            const bf16_t* src = phg + (size_t)(row0 + (ok ? r : 0)) * HGC + h * 128 + pcol * 8;
            R.gq[j] = *(const u32x4*)src; R.gk[j] = *(const u32x4*)(src + 512);
        }
        if (tid < 256) {
            const int r = tid >> 4; const bool ok = r < (TC >> 2);
            const bf16_t* src = phg + (size_t)(row0 + ((vq * 32 * TC) >> 7) + (ok ? r : 0)) * HGC + 1024 + h * 128 + pcol * 8;
            R.gv = *(const u32x4*)src;
        }
        { const int t = tt * 16 + fr; const bool ok = t < TC; R.go = *(const u32x2*)(oi + ((size_t)(h * 4 + vq) * NTOK + row0 + (ok ? t : 0)) * 32 + vt_o * 16 + fq * 4); }
        R.gdec = *(const f32x4*)(decb + (size_t)(dbase + ch) * 128 + w * 16 + fq * 4);
    };
    HgR ra, rb;
    gload(ra, 0); if (nch > 1) gload(rb, 1);
    auto body = [&](HgR& R, int ch) {
        const int row0 = rowbase + ch * 64;
#pragma unroll
        for (int j = 0; j < 2; ++j) {
            const int r = prow + j * 32; const u32x4 z4 = (u32x4){0u, 0u, 0u, 0u};
            *(LAS u32x4*)(lds + QG + r * 272 + pcol * 16) = (r < TC) ? R.gq[j] : z4;
            if (TC == 64) { const int lin = r * 128 + pcol * 8; *(LAS u32x4*)(lds + KDT + (lin >> 6) * 144 + (lin & 63) * 2) = R.gk[j]; }
            else if (r < 32) { const int lin = r * 128 + pcol * 8; *(LAS u32x4*)(lds + KDT + (lin >> 5) * 144 + (lin & 31) * 2) = R.gk[j]; }
        }
        if (TC == 32 && tid < 256) {
#pragma unroll
            for (int j = 0; j < 2; ++j) { const int i2 = tid + j * 256; *(LAS u32x4*)(lds + KDT + (i2 >> 2) * 144 + 64 + (i2 & 3) * 16) = (u32x4){0u, 0u, 0u, 0u}; }
        }
        if (tid < 256) {
            const int r = tid >> 4; const int lin = r * 128 + pcol * 8;
            if (TC == 64) *(LAS u32x4*)(lds + VT + (lin >> 6) * 144 + (lin & 63) * 2) = R.gv;
            else { if (r < 8) *(LAS u32x4*)(lds + VT + (lin >> 5) * 144 + (lin & 31) * 2) = R.gv;
                   *(LAS u32x4*)(lds + VT + (tid >> 3) * 144 + 64 + (tid & 3) * 16 + ((tid >> 2) & 1) * 0) = (u32x4){0u, 0u, 0u, 0u}; }
        }
#pragma unroll
        for (int vt = 0; vt < 2; ++vt) { u32x2 wv; wv.x = cvt_pk_bf16(S[vt][0], S[vt][1]); wv.y = cvt_pk_bf16(S[vt][2], S[vt][3]); *(LAS u32x2*)(lds + ST + (vt * 16 + fr) * 272 + (w * 16 + fq * 4) * 2) = wv; }
        const float oi0 = bf_lo(R.go.x), oi1 = bf_hi(R.go.x), oi2 = bf_lo(R.go.y), oi3 = bf_hi(R.go.y);
        S[0] = S[0] * R.gdec; S[1] = S[1] * R.gdec;
        __syncthreads();
        if (ch + 2 < nch) gload(R, ch + 2);
        {
            f32x4 a = {0.f, 0.f, 0.f, 0.f};
#pragma unroll
            for (int ks = 0; ks < 4; ++ks) {
                const bf16x8 sf = *(const LAS bf16x8*)(lds + ST + (vt_o * 16 + fr) * 272 + (ks * 32 + fq * 8) * 2);
                const bf16x8 qf = *(const LAS bf16x8*)(lds + QG + (tt * 16 + fr) * 272 + (ks * 32 + fq * 8) * 2);
                a = __builtin_amdgcn_mfma_f32_16x16x32_bf16(sf, qf, a, 0, 0, 0);
            }
            const int t = tt * 16 + fr;
            if (t < TC) {
                u32x2 wv; wv.x = cvt_pk_bf16(a[0] + oi0, a[1] + oi1); wv.y = cvt_pk_bf16(a[2] + oi2, a[3] + oi3);
                *(u32x2*)((bf16_t*)oi + ((size_t)(h * 4 + vq) * NTOK + row0 + t) * 32 + vt_o * 16 + fq * 4) = wv;
            }
        }
#pragma unroll
        for (int vt = 0; vt < 2; ++vt) {
#pragma unroll
            for (int ks = 0; ks < 2; ++ks) {
                const bf16x8 kf = *(const LAS bf16x8*)(lds + KDT + (w * 16 + fr) * 144 + (ks * 32 + fq * 8) * 2);
                const bf16x8 vf = *(const LAS bf16x8*)(lds + VT + (vt * 16 + fr) * 144 + (ks * 32 + fq * 8) * 2);
                S[vt] = __builtin_amdgcn_mfma_f32_16x16x32_bf16(kf, vf, S[vt], 0, 0, 0);
            }
        }
        __syncthreads();
    };
#pragma unroll 1
    for (int ch = 0; ch < nch; ch += 2) { body(ra, ch); if (ch + 1 < nch) body(rb, ch + 1); }
#pragma unroll
    for (int vt = 0; vt < 2; ++vt)
#pragma unroll
        for (int j = 0; j < 4; ++j) Sout[(w * 16 + fq * 4 + j) * 128 + vq * 32 + vt * 16 + fr] = S[vt][j];
}
__device__ __forceinline__ void ph_hgseq(const Params& p, LAS unsigned char* lds, int first, int nblk) {
#pragma unroll 1
    for (int t = (int)blockIdx.x - first; t < 384; t += nblk) hg_seq(p, lds, t);
}
__device__ __forceinline__ void ph_scan(const Params& p, LAS unsigned char* lds) {
#pragma unroll 1
    for (int task = blockIdx.x; task < 768; task += gridDim.x) {
        if (task < 256) { const int b = task >> 5, h = (task >> 2) & 7, q4 = task & 3; rwkv_scan(p, lds, b * 4096, 4096, h, q4, nullptr, p.out + O_PRW + (size_t)(b * 8 + h) * 4096); }
        else { const int t = task - 256, b = t >> 5, h = (t >> 2) & 7, q4 = t & 3; rwkv_scan(p, lds, NTOKP + b * 32, 32, h, q4, p.in[6] + (size_t)(b * 8 + h) * 4096, p.out + O_SRW + (size_t)(b * 8 + h) * 4096); }
    }
}

__device__ __forceinline__ void ph_rwpost(const Params& p) {
    const int tid = opaque_tid(), lane = tid & 63, wid = tid >> 6; const int gw = blockIdx.x * 8 + wid, nw = gridDim.x * 8;
    unsigned char* ws = p.ws; bf16_t* ob = (bf16_t*)(ws + WS_B); const bf16_t* phg = (const bf16_t*)(ws + WS_PHG); const bf16_t* oi = (const bf16_t*)(ws + WS_OI);
    const bf16_t* kp = (const bf16_t*)(ws + WS_PRW); const bf16_t* gb = (const bf16_t*)(ws + WS_PRW + HALF512); const bf16_t* rb = (const bf16_t*)(ws + WS_A); const bf16_t* vb = (const bf16_t*)(ws + WS_A + HALF512);
    const int c = lane * 8; float rk[8], gw8[8], gb8[8], hn[8];
#pragma unroll
    for (int j = 0; j < 8; ++j) { rk[j] = p.in[20][c + j]; gw8[j] = p.in[21][c + j]; gb8[j] = p.in[22][c + j]; hn[j] = p.in[11][c + j]; }
    u32x4 cur[7], nxt[7];
#define RP_LD(X, row) do { const size_t o_ = (size_t)(row) * 512 + c; X[0] = *(const u32x4*)(ob + (size_t)(row) * D + 512 + c); X[1] = *(const u32x4*)(rb + o_); X[2] = *(const u32x4*)(kp + o_); \
        X[3] = *(const u32x4*)(vb + o_); X[4] = *(const u32x4*)(gb + o_); X[5] = *(const u32x4*)(oi + ((size_t)(c >> 5) * NTOK + (row)) * 32 + (c & 31)); X[6] = *(const u32x4*)(phg + (size_t)(row) * HGC + 1536 + c); } while (0)
    int row = gw;
    if (row < NTOK) RP_LD(cur, row);
#pragma unroll 1
    for (; row < NTOK; row += nw) {
        const int nr = row + nw;
        if (nr < NTOK) RP_LD(nxt, nr);
        float y[8], r[8], k[8], v[8], g[8], ho[8], hg[8];
        unpack8(cur[0], y); unpack8(cur[1], r); unpack8(cur[2], k); unpack8(cur[3], v); unpack8(cur[4], g); unpack8(cur[5], ho); unpack8(cur[6], hg);
        float s = 0.f, bs = 0.f, hs = 0.f;
#pragma unroll
        for (int j = 0; j < 8; ++j) { s += y[j]; bs += r[j] * k[j] * rk[j]; hs += ho[j] * ho[j]; }
        s = red8(s); bs = red8(bs); hs = red16(hs); const float mean = s * (1.0f / 64.0f); float q = 0.f;
#pragma unroll
        for (int j = 0; j < 8; ++j) { const float d = y[j] - mean; q += d * d; }
        q = red8(q); const float rstd = rsqrtf(q * (1.0f / 64.0f) + 64e-5f); const float hrs = rsqrtf(hs * (1.0f / 128.0f) + 1e-6f); float out[8], hout[8];
#pragma unroll
        for (int j = 0; j < 8; ++j) { out[j] = ((y[j] - mean) * rstd * gw8[j] + gb8[j] + bs * v[j]) * g[j]; hout[j] = ho[j] * hrs * hn[j] * (hg[j] * sigmoidf_(hg[j])); }
        *(u32x4*)(ob + (size_t)row * D + 512 + c) = pack8(out);
        *(u32x4*)(ob + (size_t)row * D + c) = pack8(hout);
#pragma unroll
        for (int i = 0; i < 7; ++i) cur[i] = nxt[i];
    }
#undef RP_LD
}

__device__ __forceinline__ void ph_attn(const Params& p, LAS unsigned char* lds) {
    const int tid = opaque_tid(), lane = tid & 63, w = __builtin_amdgcn_readfirstlane(tid >> 6), fr = lane & 15, fq = lane >> 4;
    unsigned char* ws = p.ws; const bf16_t* qb = (const bf16_t*)(ws + WS_A); const bf16_t* kb = (const bf16_t*)(ws + WS_KB); const bf16_t* vt = (const bf16_t*)(ws + WS_VT); bf16_t* ao = (bf16_t*)(ws + WS_B);
    constexpr int PR = 36864;
    LAS unsigned char* pw = lds + PR + w * 8448 + fr * 528 + fq * 8;
    const unsigned koff = (unsigned)((tid >> 5) * 1024 + (tid & 31) * 8);
    const unsigned voff = (unsigned)((tid >> 3) * 256 + (tid & 7) * 8);
    LAS unsigned char* kst = lds + (tid >> 5) * 528 + (tid & 31) * 16;
    LAS unsigned char* vst = lds + (tid >> 3) * 144 + (tid & 7) * 16;
    const LAS unsigned char* krd = lds + fr * 528 + fq * 16;
    const LAS unsigned char* vrd = lds + fr * 144 + fq * 16;
#pragma unroll 1
    for (int u = blockIdx.x; u < 1088; u += gridDim.x) {
        int r0, nrows, kvb, h;
        if (u < 1024) { const int tile = u >> 2; h = u & 3; r0 = tile * 128; nrows = 128; kvb = tile >> 5; }
        else { const int s = u - 1024, b = s >> 2; h = s & 3; r0 = NTOKP + b * 32; nrows = 32; kvb = 8 + b; }
        const bool active = (w * 16) < nrows;
        bf16x8 qf[8];
        if (active) {
            const bf16_t* qp = qb + (size_t)(r0 + w * 16 + fr) * D + h * 256 + fq * 8;
#pragma unroll
            for (int ks = 0; ks < 8; ++ks) qf[ks] = *(const bf16x8*)(qp + ks * 32);
        }
        u32x4 st[4];
        const bf16_t* kbase = kb + (size_t)kvb * 256 * 1024 + h * 256; const bf16_t* vbase = vt + ((size_t)kvb * 1024 + h * 256) * 256;
#define LOADK(i) do { _Pragma("unroll") for (int j = 0; j < 4; ++j) st[j] = *(const u32x4*)(kbase + ((i) * 64 + j * 16) * 1024 + koff); } while (0)
#define LOADV(i) do { _Pragma("unroll") for (int j = 0; j < 4; ++j) st[j] = *(const u32x4*)(vbase + (j * 64 * 256 + (i) * 64) + voff); } while (0)
#define STOREK() do { _Pragma("unroll") for (int j = 0; j < 4; ++j) *(LAS u32x4*)(kst + j * 16 * 528) = st[j]; } while (0)
#define STOREV() do { _Pragma("unroll") for (int j = 0; j < 4; ++j) *(LAS u32x4*)(vst + j * 64 * 144) = st[j]; } while (0)
        f32x4 sc[16];
        LOADK(0);
#pragma unroll
        for (int i = 0; i < 4; ++i) {
            __syncthreads(); STOREK(); __syncthreads();
            if (i < 3) LOADK(i + 1); else LOADV(0);
            if (active) {
#pragma unroll
                for (int sub = 0; sub < 4; ++sub) {
                    f32x4 a = {0.f, 0.f, 0.f, 0.f};
#pragma unroll
                    for (int ks = 0; ks < 8; ++ks) {
                        const bf16x8 kf = *(const LAS bf16x8*)(krd + sub * 16 * 528 + ks * 64);
                        a = __builtin_amdgcn_mfma_f32_16x16x32_bf16(kf, qf[ks], a, 0, 0, 0);
                    }
                    sc[i * 4 + sub] = a;
                }
            }
        }
        float linv = 0.f;
        if (active) {
            float mx = -3.0e38f;
#pragma unroll
            for (int t = 0; t < 16; ++t)
#pragma unroll
                for (int j = 0; j < 4; ++j) mx = fmaxf(mx, sc[t][j]);
            mx = fmaxf(mx, __shfl_xor(mx, 16)); mx = fmaxf(mx, __shfl_xor(mx, 32));
            float l = 0.f;
#pragma unroll
            for (int t = 0; t < 16; ++t) {
                float e[4];
#pragma unroll
                for (int j = 0; j < 4; ++j) { e[j] = __expf(sc[t][j] - mx); l += e[j]; }
                u32x2 wv; wv.x = cvt_pk_bf16(e[0], e[1]); wv.y = cvt_pk_bf16(e[2], e[3]);
                *(LAS u32x2*)(pw + t * 32) = wv;
            }
            l += __shfl_xor(l, 16); l += __shfl_xor(l, 32); linv = 1.0f / l;
        }
        f32x4 oa[16];
#pragma unroll
        for (int dt = 0; dt < 16; ++dt) oa[dt] = (f32x4){0.f, 0.f, 0.f, 0.f};
#pragma unroll 1
        for (int i = 0; i < 4; ++i) {
            __syncthreads(); STOREV(); __syncthreads();
            if (i < 3) LOADV(i + 1);
            if (active) {
#pragma unroll
                for (int ks = 0; ks < 2; ++ks) {
                    const bf16x8 pf = *(const LAS bf16x8*)(pw + fq * 8 + i * 128 + ks * 64);
#pragma unroll
                    for (int dt = 0; dt < 16; ++dt) {
                        const bf16x8 vf = *(const LAS bf16x8*)(vrd + dt * 16 * 144 + ks * 64);
                        oa[dt] = __builtin_amdgcn_mfma_f32_16x16x32_bf16(vf, pf, oa[dt], 0, 0, 0);
                    }
                }
            }
        }
        if (active) {
            bf16_t* dst = ao + (size_t)(r0 + w * 16 + fr) * D + h * 256 + fq * 4;
#pragma unroll
            for (int dt = 0; dt < 16; ++dt) { u32x2 wv; wv.x = cvt_pk_bf16(oa[dt][0] * linv, oa[dt][1] * linv); wv.y = cvt_pk_bf16(oa[dt][2] * linv, oa[dt][3] * linv); *(u32x2*)(dst + dt * 16) = wv; }
        }
        __syncthreads();
#undef LOADK
#undef LOADV
#undef STOREK
#undef STOREV
    }
}

__device__ __forceinline__ void ph_final(const Params& p) {
    const int tid = opaque_tid(), lane = tid & 63, wid = tid >> 6; const int gw = blockIdx.x * 8 + wid, nw = gridDim.x * 8;
    f32x4 gn[4], cur[4], nxt[4];
#pragma unroll
    for (int i = 0; i < 4; ++i) gn[i] = ((const f32x4*)p.in[34])[i * 64 + lane];
    int row = gw;
    if (row < NTOK) { const f32x4* x = (const f32x4*)(p.out + (size_t)row * D);
#pragma unroll
        for (int i = 0; i < 4; ++i) cur[i] = x[i * 64 + lane]; }
#pragma unroll 1
    for (; row < NTOK; row += nw) {
        const int nr = row + nw;
        if (nr < NTOK) { const f32x4* x = (const f32x4*)(p.out + (size_t)nr * D);
#pragma unroll
            for (int i = 0; i < 4; ++i) nxt[i] = x[i * 64 + lane]; }
        float ss = 0.f;
#pragma unroll
        for (int i = 0; i < 4; ++i) ss += (cur[i][0] * cur[i][0] + cur[i][1] * cur[i][1]) + (cur[i][2] * cur[i][2] + cur[i][3] * cur[i][3]);
        ss = red64(ss); const float rs = rsqrtf(ss * (1.0f / 1024.0f) + 1e-6f);
        f32x4* xo = (f32x4*)(p.out + (size_t)row * D);
#pragma unroll
        for (int i = 0; i < 4; ++i) xo[i * 64 + lane] = cur[i] * rs * gn[i];
#pragma unroll
        for (int i = 0; i < 4; ++i) cur[i] = nxt[i];
    }
}

#define XB_TMO      128
#define XB_XCNT(j)  (256  + 64 * (j))
#define XB_XSUB(j)  (1280 + 64 * (j))
#define XB_XGEN(j)  (2304 + 64 * (j))
#define XB_TOP      3328
#define XB_TOPGEN   3392
#define XCD_BAR_WORDS 3456
#define XB_SPIN_CAP (1u << 18)

__device__ __forceinline__ unsigned xb_ld(unsigned* p)              { return __hip_atomic_load(p, __ATOMIC_RELAXED, __HIP_MEMORY_SCOPE_AGENT); }
__device__ __forceinline__ unsigned xb_add(unsigned* p, unsigned v) { return __hip_atomic_fetch_add(p, v, __ATOMIC_RELAXED, __HIP_MEMORY_SCOPE_AGENT); }
__device__ __forceinline__ unsigned xb_xcc_id() { return (unsigned)__builtin_amdgcn_s_getreg((3 << 11) | 20) & 0xFu; }
#define XB_SPIN(cond, bar) do { unsigned _sp = 0; while (cond) { __builtin_amdgcn_s_sleep(1); \
    if ((++_sp & 255u) == 0u) { if (xb_ld(&(bar)[XB_TMO])) break; if (_sp > XB_SPIN_CAP) { atomicAdd(&(bar)[XB_TMO], 1u); break; } } } } while (0)

struct XcdBarrier {
    unsigned* bar; unsigned x;
    volatile LAS unsigned* st;
};

__device__ __forceinline__ XcdBarrier xcd_barrier_post(unsigned* bar, volatile LAS unsigned* st) {
    XcdBarrier b; b.bar = bar; b.x = xb_xcc_id(); b.st = st;
    if (threadIdx.x == 0) (void)xb_add(&bar[XB_XCNT(b.x)], 1u);
    return b;
}
__device__ __forceinline__ void xcd_barrier_complete(unsigned* bar, unsigned x, unsigned& nloc, unsigned& nx) {
    const unsigned G = gridDim.x * gridDim.y * gridDim.z;
    unsigned sum, cnt, mine, sp = 0u;
    for (;;) {
        sum = 0u; cnt = 0u; mine = 0u;
#pragma unroll
        for (unsigned j = 0; j < 16; ++j) { const unsigned c = xb_ld(&bar[XB_XCNT(j)]); sum += c; cnt += (c > 0u) ? 1u : 0u; mine = (j == x) ? c : mine; }
        if (sum == G) break;
        __builtin_amdgcn_s_sleep(1);
        if ((++sp & 255u) == 0u) { if (xb_ld(&bar[XB_TMO])) break; if (sp > XB_SPIN_CAP) { atomicAdd(&bar[XB_TMO], 1u); break; } }
    }
    nloc = mine > 0u ? mine : 1u; nx = cnt > 0u ? cnt : 1u;
}

__device__ __forceinline__ void xcd_barrier(const XcdBarrier& b) {
    asm volatile("s_waitcnt vmcnt(0)" ::: "memory");
    __syncthreads();
    if (threadIdx.x == 0) {
        unsigned* bar = b.bar;
        __builtin_amdgcn_s_waitcnt(0);
        unsigned nloc = b.st[0], nx = b.st[1];
        if (nloc == 0u) { xcd_barrier_complete(bar, b.x, nloc, nx); b.st[0] = nloc; b.st[1] = nx; }
        const unsigned old = xb_add(&bar[XB_XSUB(b.x)], 1u);
        const unsigned gen = old / nloc;
        if (old + 1u == (gen + 1u) * nloc) {
            __builtin_amdgcn_fence(__ATOMIC_RELEASE, "agent");
            asm volatile("s_waitcnt vmcnt(0)" ::: "memory");
            const unsigned og = xb_add(&bar[XB_TOP], 1u);
            const unsigned tg = og / nx;
            if (og + 1u == (tg + 1u) * nx) xb_add(&bar[XB_TOPGEN], 1u);
            else XB_SPIN(xb_ld(&bar[XB_TOPGEN]) == tg, bar);
            __builtin_amdgcn_fence(__ATOMIC_ACQUIRE, "agent");
            xb_add(&bar[XB_XGEN(b.x)], 1u);
            asm volatile("s_waitcnt vmcnt(0)" ::: "memory");
        } else {
            XB_SPIN(xb_ld(&bar[XB_XGEN(b.x)]) == gen, bar);
            __builtin_amdgcn_fence(__ATOMIC_ACQUIRE, "agent");
            asm volatile("s_waitcnt vmcnt(0)" ::: "memory");
        }
    }
    __syncthreads();
}


__device__ __forceinline__ void grid_sync_cg() {
    asm volatile("s_waitcnt vmcnt(0) lgkmcnt(0)" ::: "memory");
    __syncthreads();
    if (threadIdx.x == 0) { __builtin_amdgcn_fence(__ATOMIC_RELEASE, "agent"); asm volatile("s_waitcnt vmcnt(0)" ::: "memory"); }
    cg::this_grid().sync();
    if (threadIdx.x < 64) { __builtin_amdgcn_fence(__ATOMIC_ACQUIRE, "agent"); asm volatile("s_waitcnt vmcnt(0)" ::: "memory"); }
    __syncthreads();
}
__device__ __forceinline__ void grid_sync_fast(unsigned* bar, unsigned& epoch) {
    asm volatile("s_waitcnt vmcnt(0) lgkmcnt(0)" ::: "memory");
    __syncthreads();
    epoch += 1;
    if (threadIdx.x == 0) {
        __builtin_amdgcn_fence(__ATOMIC_RELEASE, "agent");
        asm volatile("s_waitcnt vmcnt(0)" ::: "memory");
        __hip_atomic_fetch_add(bar, 1u, __ATOMIC_RELAXED, __HIP_MEMORY_SCOPE_AGENT);
        const unsigned target = epoch * gridDim.x;
        while (__hip_atomic_load(bar, __ATOMIC_RELAXED, __HIP_MEMORY_SCOPE_AGENT) < target) __builtin_amdgcn_s_sleep(2);
        __builtin_amdgcn_fence(__ATOMIC_ACQUIRE, "agent");
        asm volatile("s_waitcnt vmcnt(0)" ::: "memory");
    }
    __syncthreads();
}
__global__ void __launch_bounds__(512, 2) mk_fwd(Params p) {
    extern __shared__ __attribute__((aligned(16))) unsigned char smem[];
    LAS unsigned char* lds = (LAS unsigned char*)smem;
    unsigned char* ws = p.ws; const int G = gridDim.x, bid = blockIdx.x;
    volatile LAS unsigned* st_ = (volatile LAS unsigned*)(lds + 131072);
    if (threadIdx.x == 0) { st_[0] = 0u; st_[1] = 0u; }
    __syncthreads();
    const XcdBarrier xb_ = xcd_barrier_post((unsigned*)(ws + WS_BAR), st_);
#ifndef PHMASK
#define PHMASK 0x1fff
#endif
#define IN(k) (((PHMASK >> (k)) & 1) && p.lo <= (k) && (k) < p.hi)
#ifndef DUPMASK
#define DUPMASK 0
#endif
#define REPS(k) for (int rep_ = 0; rep_ < 1 + ((DUPMASK >> (k)) & 1); ++rep_)
#define RSYNC() do { if (rep_) xcd_barrier(xb_); } while (0)
#define SEAM(k) do { if (IN(k) && IN((k) + 1)) xcd_barrier(xb_); } while (0)
    if (p.lo > 1000) grid_sync_cg();
    if (IN(0)) REPS(0) { RSYNC(); ph_prep(p, lds); }
    SEAM(0);
    if (IN(1)) REPS(1) { RSYNC();
        { pg8::Gemm g{(const bf16_t*)(ws + WS_A), (const bf16_t*)(ws + WS_WIN), NTOK, 3840, 1024}; pg8::StaticOrder S; S.init(NTOK, 3840, G, bid);
          EpiWin E{(bf16_t*)(ws + WS_PHG), (bf16_t*)(ws + WS_PRW), (const float*)(ws + WS_RS0), p.out + O_PSH, p.out + O_SSH}; pg8::gemm_phase(lds, g, S, E); }
        { pg8::Gemm g{(const bf16_t*)(ws + WS_MEMB), (const bf16_t*)(ws + WS_WKV), 2048, 2048, 1024}; pg8::StaticOrder S; S.init(2048, 2048, G, (bid + G - 160 % G) % G);
          EpiMemKV E{p.out + O_PMK, p.out + O_PMV, (const float*)(ws + WS_RSM)}; pg8::gemm_phase(lds, g, S, E); }
    }
    SEAM(1);
    if (IN(2)) { ph_rwprep(p); ph_kvconv(p, lds); ph_hgprep(p, lds); }
    SEAM(2);
    if (IN(3)) {
        const bool split = (G == 256);
        pg8::Gemm g{(const bf16_t*)(ws + WS_B), (const bf16_t*)(ws + WS_WLORA), NTOK, 1536, 256}; pg8::StaticOrder S;
        EpiLora E{p.out, (bf16_t*)((unsigned char*)p.out + 68157440), (bf16_t*)((unsigned char*)p.out + 68157440 + HALF512), (bf16_t*)(ws + WS_PRW), (bf16_t*)(ws + WS_PRW + HALF512),
                  (const bf16_t*)(ws + WS_B + 17039360), (const float*)(ws + WS_KKN), p.in[13], p.in[15], p.in[18], p.in[19]};
        if (!split) { S.init(NTOK, 1536, G, bid); pg8::gemm_phase(lds, g, S, E); __syncthreads(); ph_hgseq(p, lds, 0, G); }
        else {
            if (bid < 128) { S.init(NTOK, 1536, 128, bid); S.window(0, 640); }
            else { ph_hgseq(p, lds, 128, 128); __syncthreads(); S.init(NTOK, 1536, 128, bid - 128); S.window(640, 780); }
            pg8::gemm_phase(lds, g, S, E);
        }
    }
    SEAM(3);
    if (IN(4)) REPS(4) { RSYNC(); ph_scan(p, lds); }
    SEAM(4);
    if (IN(5)) ph_rwpost(p);
    SEAM(5);
    if (IN(6)) {
        sgemm_sample<0>(lds, (const bf16_t*)(ws + WS_B), (const bf16_t*)(ws + WS_WOUT), 1024, p.in[2], p.out, (bf16_t*)(ws + WS_PRW), (float*)(ws + WS_SSQ1), nullptr);
        pg8::Gemm g{(const bf16_t*)(ws + WS_B), (const bf16_t*)(ws + WS_WOUT), NTOKP, 1024, 1024}; pg8::StaticOrder S; S.init(NTOKP, 1024, G, bid);
        EpiRes E{p.in[0], p.in[2], p.out, (bf16_t*)(ws + WS_PRW), (float*)(ws + WS_SSQ1)}; pg8::gemm_phase(lds, g, S, E);
    }
    SEAM(6);
    if (IN(7)) {
        sgemm_sample<1>(lds, (const bf16_t*)(ws + WS_PRW), (const bf16_t*)(ws + WS_WCQ), 1024, nullptr, nullptr, (bf16_t*)(ws + WS_A), nullptr, (const float*)(ws + WS_SSQ1));
        pg8::Gemm g{(const bf16_t*)(ws + WS_PRW), (const bf16_t*)(ws + WS_WCQ), NTOKP, 1024, 1024}; pg8::StaticOrder S; S.init(NTOKP, 1024, G, bid);
        EpiQ E{(bf16_t*)(ws + WS_A), (const float*)(ws + WS_SSQ1)}; pg8::gemm_phase(lds, g, S, E);
    }
    SEAM(7);
    if (IN(8)) REPS(8) { RSYNC(); ph_attn(p, lds); }
    SEAM(8);
    if (IN(9)) {
        sgemm_sample<0>(lds, (const bf16_t*)(ws + WS_B), (const bf16_t*)(ws + WS_WCO), 1024, p.out + (size_t)NTOKP * D, p.out, (bf16_t*)(ws + WS_A), (float*)(ws + WS_SSQ2), nullptr);
        pg8::Gemm g{(const bf16_t*)(ws + WS_B), (const bf16_t*)(ws + WS_WCO), NTOKP, 1024, 1024}; pg8::StaticOrder S; S.init(NTOKP, 1024, G, bid);
        EpiRes E{p.out, p.out + (size_t)NTOKP * D, p.out, (bf16_t*)(ws + WS_A), (float*)(ws + WS_SSQ2)}; pg8::gemm_phase(lds, g, S, E);
    }
    SEAM(9);
    if (IN(10)) REPS(10) { RSYNC();
        pg8::Gemm g{(const bf16_t*)(ws + WS_A), (const bf16_t*)(ws + WS_WFF13), NTOK, 5632, 1024}; pg8::StaticOrder S; S.init(NTOK, 5632, G, bid);
        EpiFF13 E{(bf16_t*)(ws + WS_PHG), (const float*)(ws + WS_SSQ2)}; pg8::gemm_phase(lds, g, S, E);
    }
    SEAM(10);
    if (IN(11)) {
        sgemm_sample<0>(lds, (const bf16_t*)(ws + WS_PHG), (const bf16_t*)(ws + WS_WFF2), 2816, p.out + (size_t)NTOKP * D, p.out, nullptr, nullptr, nullptr);
        pg8::Gemm g{(const bf16_t*)(ws + WS_PHG), (const bf16_t*)(ws + WS_WFF2), NTOKP, 1024, 2816}; pg8::StaticOrder S; S.init(NTOKP, 1024, G, bid);
        EpiRes E{p.out, p.out + (size_t)NTOKP * D, p.out, nullptr, nullptr}; pg8::gemm_phase(lds, g, S, E);
    }
    SEAM(11);
    if (IN(12)) ph_final(p);
#undef IN
#undef SEAM
}

extern "C" void kernel_launch(void* const* d_in, const int* in_sizes, int n_in, void* d_out, int out_size, void* d_ws, size_t ws_size, hipStream_t stream) {
    static int grid = 0;
    if (grid == 0) {
        if (n_in != 35 || ws_size < WS_END) { fprintf(stderr, "kernel_launch: unexpected n_in %d or ws %zu < %zu\n", n_in, ws_size, (size_t)WS_END); grid = -1; return; }
        if (hipFuncSetAttribute((const void*)mk_fwd, hipFuncAttributeMaxDynamicSharedMemorySize, LDS_BYTES) != hipSuccess) { fprintf(stderr, "kernel_launch: hipFuncSetAttribute failed\n"); grid = -1; return; }
        int dev = 0, cus = 0, per_cu = 0;
        hipGetDevice(&dev); hipDeviceGetAttribute(&cus, hipDeviceAttributeMultiprocessorCount, dev);
        hipOccupancyMaxActiveBlocksPerMultiprocessor(&per_cu, (const void*)mk_fwd, 512, LDS_BYTES);
        (void)hipGetLastError();
        if (per_cu < 1) per_cu = 1;
        grid = cus > 0 ? cus : 256;
    }
    if (grid < 0) return;
    if (hipMemsetAsync((char*)d_ws + WS_BAR, 0, 14080, stream) != hipSuccess) { fprintf(stderr, "kernel_launch: memset of the barrier word failed\n"); return; }
    Params p{};
    for (int i = 0; i < 35; ++i) p.in[i] = (const float*)d_in[i];
    p.out = (float*)d_out; p.ws = (unsigned char*)d_ws;
#if MK_MULTI
    for (int ph = 0; ph < NPHASE; ++ph) { p.lo = ph; p.hi = ph + 1; hipLaunchKernelGGL(mk_fwd, dim3(grid), dim3(512), LDS_BYTES, stream, p); }
#else
    p.lo = 0; p.hi = NPHASE;
    void* args[] = {&p};
    hipError_t e = hipLaunchCooperativeKernel((const void*)mk_fwd, dim3(grid), dim3(512), args, LDS_BYTES, stream);
    if (e != hipSuccess) fprintf(stderr, "cooperative launch failed: %s (grid %d)\n", hipGetErrorString(e), grid);
#endif
}
```

```cpp
#include <hip/hip_runtime.h>
#include <hip/hip_cooperative_groups.h>
#include <cstdio>
namespace cg = cooperative_groups;

#ifndef MK_MULTI
#define MK_MULTI 0
#endif

#define LAS __attribute__((address_space(3)))
typedef unsigned short bf16_t;
typedef short bf16x8 __attribute__((ext_vector_type(8)));
typedef float f32x4 __attribute__((ext_vector_type(4)));
typedef float f32x2 __attribute__((ext_vector_type(2)));
typedef unsigned u32x4 __attribute__((ext_vector_type(4)));
typedef unsigned u32x2 __attribute__((ext_vector_type(2)));

constexpr int D = 1024, NTOKP = 32768, NTOKS = 512, NTOK = 33280, HGC = 2048, RWC = 1792, DFF = 2816;
constexpr int NPHASE = 13;
constexpr int LDS_BYTES = 131072 + 16;

constexpr size_t O_Y = 0, O_PHG = 34078720, O_PRW = 34603008, O_PSH = 34865152, O_PMK = 34879488, O_PMV = 36976640,
                 O_SHG = 39073792, O_SRW = 40122368, O_SSH = 40646656;
constexpr size_t WS_WIN = 0;
constexpr size_t WS_WLORA = WS_WIN + 7864320;
constexpr size_t WS_WOUT = WS_WLORA + 786432;
constexpr size_t WS_WCQ = WS_WOUT + 2097152;
constexpr size_t WS_WKV = WS_WCQ + 2097152;
constexpr size_t WS_WCO = WS_WKV + 4194304;
constexpr size_t WS_WFF13 = WS_WCO + 2097152;
constexpr size_t WS_WFF2 = WS_WFF13 + 11534336;
constexpr size_t WS_PHG = WS_WFF2 + 5767168;
constexpr size_t WS_PRW = WS_PHG + 136314880;
constexpr size_t WS_A = WS_PRW + 119275520;
constexpr size_t WS_B = WS_A + 68157440;
constexpr size_t WS_MEMB = WS_B + 68157440;
constexpr size_t WS_KB = WS_MEMB + 4194304;
constexpr size_t WS_VT = WS_KB + 12582912;
constexpr size_t WS_RS0 = WS_VT + 12582912;
constexpr size_t WS_RSM = WS_RS0 + 133120;
constexpr size_t WS_KKN = WS_RSM + 8192;
constexpr size_t WS_SSQ1 = WS_KKN + 1064960;
constexpr size_t WS_SSQ2 = WS_SSQ1 + 2129920;
constexpr size_t WS_OI = WS_SSQ2 + 2129920;
constexpr size_t WS_DECB = WS_OI + 34078720;
constexpr size_t WS_BAR = WS_DECB + 1081344;
constexpr size_t WS_END = WS_BAR + 14080;
constexpr size_t HALF512 = 34078720;

struct Params {
    const float* in[35];
    float* out;
    unsigned char* ws;
    int lo, hi;
};

typedef __bf16 bf16x2_t __attribute__((ext_vector_type(2)));
__device__ __forceinline__ unsigned cvt_pk_bf16(float lo, float hi) { f32x2 f = {lo, hi}; bf16x2_t v = __builtin_convertvector(f, bf16x2_t); return __builtin_bit_cast(unsigned, v); }
__device__ __forceinline__ float bf_lo(unsigned w) { return __uint_as_float(w << 16); }
__device__ __forceinline__ float bf_hi(unsigned w) { return __uint_as_float(w & 0xffff0000u); }
__device__ __forceinline__ float bf1(bf16_t b) { return __uint_as_float(((unsigned)b) << 16); }
__device__ __forceinline__ bf16_t f2bf(float f) { return (bf16_t)(cvt_pk_bf16(f, 0.f) & 0xffffu); }
__device__ __forceinline__ float sigmoidf_(float x) { return __builtin_amdgcn_rcpf(1.0f + __expf(-x)); }
__device__ __forceinline__ void unpack8(const u32x4 w, float* f) {
    f[0] = bf_lo(w.x); f[1] = bf_hi(w.x); f[2] = bf_lo(w.y); f[3] = bf_hi(w.y); f[4] = bf_lo(w.z); f[5] = bf_hi(w.z); f[6] = bf_lo(w.w); f[7] = bf_hi(w.w);
}
__device__ __forceinline__ u32x4 pack8(const float* f) {
    u32x4 w; w.x = cvt_pk_bf16(f[0], f[1]); w.y = cvt_pk_bf16(f[2], f[3]); w.z = cvt_pk_bf16(f[4], f[5]); w.w = cvt_pk_bf16(f[6], f[7]); return w;
}
__device__ __forceinline__ int opaque_tid() { int t = threadIdx.x; asm volatile("" : "+v"(t)); return t; }
template <int CTRL> __device__ __forceinline__ float dppf(float x) {
    return __int_as_float(__builtin_amdgcn_update_dpp(0, __float_as_int(x), CTRL, 0xf, 0xf, true));
}
__device__ __forceinline__ float red4(float x) { x += dppf<0xB1>(x); x += dppf<0x4E>(x); return x; }
__device__ __forceinline__ float red8(float x) { x = red4(x); x += dppf<0x141>(x); return x; }
__device__ __forceinline__ float red16(float x) { x = red8(x); x += dppf<0x140>(x); return x; }
__device__ __forceinline__ float red64(float x) { x = red16(x); x += __shfl_xor(x, 16); x += __shfl_xor(x, 32); return x; }

namespace pg8 {
constexpr int BM = 256, BK = 64, HALF = 128, HTB = HALF * BK * 2, STAGE_BYTES = 8 * HTB, NXCD = 8, WGM = 8;
__device__ __forceinline__ int lds_byte(int r, int c) { const int st = (r >> 4) * 2 + (c >> 5), rr = r & 15, cc = c & 31, ob = rr * 64 + cc * 2; return st * 1024 + (ob ^ (((ob >> 9) & 1) << 5)); }
__device__ __forceinline__ void stage_rc(int b, int& R, int& C) { const int st = b / 1024, sb = b % 1024, swz = sb ^ (((sb >> 9) & 1) << 5); R = (st >> 1) * 16 + swz / 64; C = (st & 1) * 32 + (swz % 64) / 2; }
__device__ __forceinline__ int perm32(int rho) { const int n = rho >> 4, i = rho & 15; return 8 * (i >> 2) + 4 * n + (i & 3); }
struct Unit { int pm, pn; };
struct Gemm { const bf16_t* A; const bf16_t* Bt; int M, N, K; };
struct StaticOrder {
    int nM, nN, nwg, G, c, base, cap;
    __device__ __forceinline__ void init(int M, int N, int G_, int c_) { nM = M / BM; nN = N / BM; nwg = nM * nN; G = G_; c = c_; base = 0; cap = nwg; }
    __device__ __forceinline__ void window(int base_, int cap_) { base = base_; cap = cap_ < nwg ? cap_ : nwg; }
    __device__ bool next(int i, Unit& u) const {
        const long L = (long)base + (long)i * G + c; if (L >= cap) return false;
        int wgid = (int)L; { const int q = nwg / NXCD, r = nwg % NXCD, xcd = wgid % NXCD, off = wgid / NXCD; wgid = (xcd < r ? xcd * (q + 1) : r * (q + 1) + (xcd - r) * q) + off; }
        const int nig = WGM * nN, gid = wgid / nig, fm = gid * WGM, gsz = (nM - fm) < WGM ? (nM - fm) : WGM;
        u.pm = fm + ((wgid % nig) % gsz); u.pn = (wgid % nig) / gsz; return true;
    }
};
template <class Epi, bool ALIGN_EPI = true, bool SP2 = true>
__device__ __forceinline__ void gemm_phase(LAS unsigned char* lds, const Gemm g, const StaticOrder& S, const Epi& E) {
    const int tid = opaque_tid(), wid = __builtin_amdgcn_readfirstlane(tid >> 6), lane = tid & 63, wr = wid >> 2, wc = wid & 3, fr = lane & 15, fq = lane >> 4;
    const int K = g.K, nt = K / BK;
    unsigned voffA[2], voffB[2];
#pragma unroll
    for (int i = 0; i < 2; ++i) { int R, C; stage_rc(tid * 16 + i * 8192, R, C); const int Rb = Epi::PERM ? ((R & ~31) + perm32(R & 31)) : R;
        voffA[i] = (unsigned)(R * K + C) * 2u; voffB[i] = (unsigned)(Rb * K + C) * 2u; }
    const size_t kstep = (size_t)(BK * 2);
    const size_t hstep = (size_t)HALF * K * 2;
    const size_t tstep = 2 * hstep;
    const unsigned ldsw = (unsigned)wid * 1024u;
    const int aoff = lds_byte(wr * 64 + fr, fq * 8), boff = lds_byte(wc * 32 + fr, fq * 8);
#define PG8_SA(b, h) (((b) * 2 + (h)) * HTB)
#define PG8_SB(b, h) ((4 + (b) * 2 + (h)) * HTB)
#define PG8_STAGE(bufoff, gbase, voff) do { _Pragma("unroll") for (int _i = 0; _i < 2; ++_i) \
        __builtin_amdgcn_global_load_lds((const unsigned*)((const char*)(gbase) + (voff)[_i]), (LAS unsigned*)(lds + (bufoff) + ldsw + _i * 8192), 16, 0, 0); } while (0)
#define PG8_LDA(dst, b, h) do { _Pragma("unroll") for (int m = 0; m < 4; ++m) _Pragma("unroll") for (int k = 0; k < 2; ++k) dst[m][k] = *(const LAS bf16x8*)(lds + PG8_SA(b, h) + aoff + m * 2048 + k * 1024); } while (0)
#define PG8_LDB(dst, b, h) do { _Pragma("unroll") for (int n = 0; n < 2; ++n) _Pragma("unroll") for (int k = 0; k < 2; ++k) dst[n][k] = *(const LAS bf16x8*)(lds + PG8_SB(b, h) + boff + n * 2048 + k * 1024); } while (0)
#define PG8_MMA(ai, bj, At, Bt) do { __builtin_amdgcn_s_setprio(1); _Pragma("unroll") for (int m = 0; m < 4; ++m) _Pragma("unroll") for (int n = 0; n < 2; ++n) _Pragma("unroll") for (int k = 0; k < 2; ++k) \
        acc[ai][bj][m][n] = __builtin_amdgcn_mfma_f32_16x16x32_bf16(Bt[n][k], At[m][k], acc[ai][bj][m][n], 0, 0, 0); __builtin_amdgcn_s_setprio(0); } while (0)
#define PG8_WAIT_V(n) asm volatile("s_waitcnt vmcnt(" #n ")" ::: "memory")
#define PG8_WAIT_L(n) asm volatile("s_waitcnt lgkmcnt(" #n ")" ::: "memory")
#define PG8_BAR __builtin_amdgcn_s_barrier()
#define PG8_SCHED __builtin_amdgcn_sched_barrier(0)
    Unit cur, nxt; int ui = 0;
    if (!S.next(0, cur)) return;
    f32x4 acc[2][2][4][2];
#pragma unroll
    for (int a = 0; a < 2; ++a)
#pragma unroll
        for (int b = 0; b < 2; ++b)
#pragma unroll
            for (int m = 0; m < 4; ++m)
#pragma unroll
                for (int n = 0; n < 2; ++n) acc[a][b][m][n] = (f32x4){0.f, 0.f, 0.f, 0.f};
    bf16x8 At[4][2], B0[2][2], B1[2][2];
    const char* cA = (const char*)g.A + (size_t)cur.pm * tstep; const char* cB = (const char*)g.Bt + (size_t)cur.pn * tstep;
    if constexpr (SP2) {
        PG8_STAGE(PG8_SB(0, 0), cB, voffB); PG8_STAGE(PG8_SB(0, 1), cB + hstep, voffB); PG8_STAGE(PG8_SA(0, 0), cA, voffA); PG8_STAGE(PG8_SA(0, 1), cA + hstep, voffA);
        if (wr == 1) PG8_BAR;
        PG8_WAIT_V(2); PG8_BAR;
        PG8_STAGE(PG8_SB(1, 0), cB + kstep, voffB); PG8_STAGE(PG8_SA(1, 0), cA + kstep, voffA); PG8_STAGE(PG8_SB(1, 1), cB + hstep + kstep, voffB);
        PG8_WAIT_V(6); PG8_BAR;
    } else {
        PG8_STAGE(PG8_SB(0, 0), cB, voffB); PG8_STAGE(PG8_SA(0, 0), cA, voffA); PG8_STAGE(PG8_SB(0, 1), cB + hstep, voffB); PG8_STAGE(PG8_SA(0, 1), cA + hstep, voffA);
        if (wr == 1) PG8_BAR;
        PG8_WAIT_V(4); PG8_BAR;
        PG8_STAGE(PG8_SB(1, 0), cB + kstep, voffB); PG8_STAGE(PG8_SA(1, 0), cA + kstep, voffA); PG8_STAGE(PG8_SB(1, 1), cB + hstep + kstep, voffB);
        PG8_WAIT_V(6); PG8_BAR;
    }
    for (;;) {
        const bool has_next = S.next(ui + 1, nxt);
        const char* nA = has_next ? (const char*)g.A + (size_t)nxt.pm * tstep : cA; const char* nB = has_next ? (const char*)g.Bt + (size_t)nxt.pn * tstep : cB;
#pragma unroll 1
        for (int t = 0; t < nt; t += 2) {
            const bool last = (t == nt - 2);
            const char* a1 = cA + (size_t)(t + 1) * kstep;
            const char* a2 = last ? nA : cA + (size_t)(t + 2) * kstep; const char* b2 = last ? nB : cB + (size_t)(t + 2) * kstep;
            const char* a3 = a2 + kstep; const char* b3 = b2 + kstep;
            if constexpr (SP2) {
            PG8_LDB(B0, 0, 0); PG8_LDB(B1, 0, 1); PG8_SCHED; PG8_LDA(At, 0, 0); PG8_STAGE(PG8_SA(1, 1), a1 + hstep, voffA);
            PG8_WAIT_V(8); PG8_WAIT_L(0); PG8_BAR; PG8_MMA(0, 0, At, B0); PG8_MMA(0, 1, At, B1); PG8_BAR; PG8_SCHED;
            PG8_LDA(At, 0, 1); PG8_STAGE(PG8_SB(0, 0), b2, voffB); PG8_STAGE(PG8_SB(0, 1), b2 + hstep, voffB); PG8_STAGE(PG8_SA(0, 0), a2, voffA);
            PG8_WAIT_V(8); PG8_WAIT_L(0); PG8_BAR; PG8_MMA(1, 0, At, B0); PG8_MMA(1, 1, At, B1); PG8_BAR; PG8_SCHED;
            PG8_LDB(B0, 1, 0); PG8_LDB(B1, 1, 1); PG8_SCHED; PG8_LDA(At, 1, 0); PG8_STAGE(PG8_SA(0, 1), a2 + hstep, voffA);
            PG8_WAIT_V(8); PG8_WAIT_L(0); PG8_BAR; PG8_MMA(0, 0, At, B0); PG8_MMA(0, 1, At, B1); PG8_BAR; PG8_SCHED;
            PG8_LDA(At, 1, 1); PG8_STAGE(PG8_SB(1, 0), b3, voffB); PG8_STAGE(PG8_SB(1, 1), b3 + hstep, voffB); PG8_STAGE(PG8_SA(1, 0), a3, voffA);
            PG8_WAIT_V(8); PG8_WAIT_L(0); PG8_BAR; PG8_MMA(1, 0, At, B0); PG8_MMA(1, 1, At, B1); PG8_BAR; PG8_SCHED;
            } else {
            PG8_LDB(B0, 0, 0); PG8_SCHED; PG8_LDA(At, 0, 0); PG8_STAGE(PG8_SA(1, 1), a1 + hstep, voffA);
            PG8_WAIT_L(8); PG8_BAR; PG8_WAIT_L(0); PG8_MMA(0, 0, At, B0); PG8_BAR; PG8_SCHED;
            PG8_LDB(B1, 0, 1); PG8_STAGE(PG8_SB(0, 0), b2, voffB);
            PG8_BAR; PG8_WAIT_L(0); PG8_MMA(0, 1, At, B1); PG8_BAR;
            PG8_LDA(At, 0, 1); PG8_STAGE(PG8_SA(0, 0), a2, voffA);
            PG8_BAR; PG8_WAIT_L(0); PG8_MMA(1, 0, At, B0); PG8_BAR; PG8_SCHED;
            PG8_STAGE(PG8_SB(0, 1), b2 + hstep, voffB);
            PG8_WAIT_V(6); PG8_BAR; PG8_MMA(1, 1, At, B1); PG8_BAR;
            PG8_LDB(B0, 1, 0); PG8_SCHED; PG8_LDA(At, 1, 0); PG8_STAGE(PG8_SA(0, 1), a2 + hstep, voffA);
            PG8_WAIT_L(8); PG8_BAR; PG8_WAIT_L(0); PG8_MMA(0, 0, At, B0); PG8_BAR; PG8_SCHED;
            PG8_LDB(B1, 1, 1); PG8_STAGE(PG8_SB(1, 0), b3, voffB);
            PG8_BAR; PG8_WAIT_L(0); PG8_MMA(0, 1, At, B1); PG8_BAR;
            PG8_LDA(At, 1, 1); PG8_STAGE(PG8_SA(1, 0), a3, voffA);
            PG8_BAR; PG8_WAIT_L(0); PG8_MMA(1, 0, At, B0); PG8_BAR; PG8_SCHED;
            PG8_STAGE(PG8_SB(1, 1), b3 + hstep, voffB);
            PG8_WAIT_V(6); PG8_BAR; PG8_MMA(1, 1, At, B1); PG8_BAR;
            }
        }
        if constexpr (ALIGN_EPI) { if (wr == 0) PG8_BAR; }
        E(acc, cur, wr, wc, fr, fq);
        if (!has_next) break;
#pragma unroll
        for (int a = 0; a < 2; ++a)
#pragma unroll
            for (int b = 0; b < 2; ++b)
#pragma unroll
                for (int m = 0; m < 4; ++m)
#pragma unroll
                    for (int n = 0; n < 2; ++n) acc[a][b][m][n] = (f32x4){0.f, 0.f, 0.f, 0.f};
        cur = nxt; cA = nA; cB = nB; ++ui;
        if constexpr (ALIGN_EPI) { if (wr == 1) PG8_BAR; }
    }
    PG8_WAIT_V(0);
    if constexpr (!ALIGN_EPI) { if (wr == 0) PG8_BAR; }
    PG8_BAR;
#undef PG8_SA
#undef PG8_SB
#undef PG8_STAGE
#undef PG8_LDA
#undef PG8_LDB
#undef PG8_MMA
#undef PG8_WAIT_V
#undef PG8_WAIT_L
#undef PG8_BAR
#undef PG8_SCHED
}
}
using pg8::Unit;

__device__ __forceinline__ u32x4 pack_acc8(const f32x4 a, const f32x4 b, float s) {
    u32x4 w; w.x = cvt_pk_bf16(a[0] * s, a[1] * s); w.y = cvt_pk_bf16(a[2] * s, a[3] * s); w.z = cvt_pk_bf16(b[0] * s, b[1] * s); w.w = cvt_pk_bf16(b[2] * s, b[3] * s); return w;
}
__device__ __forceinline__ float rs_from_parts(const float* sp) {
    const f32x4 a = *(const f32x4*)sp, b = *(const f32x4*)(sp + 4), c = *(const f32x4*)(sp + 8), d = *(const f32x4*)(sp + 12);
    const float s = ((a[0] + a[1]) + (a[2] + a[3])) + ((b[0] + b[1]) + (b[2] + b[3])) + ((c[0] + c[1]) + (c[2] + c[3])) + ((d[0] + d[1]) + (d[2] + d[3]));
    return rsqrtf(s * (1.0f / 1024.0f) + 1e-6f);
}

__device__ __forceinline__ float rs_from_parts4(const float* sp, int fq) {
    const f32x4 a = *(const f32x4*)(sp + fq * 4); float s = (a[0] + a[1]) + (a[2] + a[3]);
    s += __shfl_xor(s, 16); s += __shfl_xor(s, 32);
    return rsqrtf(s * (1.0f / 1024.0f) + 1e-6f);
}
struct EpiWin {
    static constexpr bool PERM = true;
    bf16_t* phg; bf16_t* prw; const float* rs0; float* psh; float* ssh;
    __device__ __forceinline__ void operator()(const f32x4 (&acc)[2][2][4][2], const Unit& u, int wr, int wc, int fr, int fq) const {
        const int row0 = u.pm * 256 + wr * 64 + fr;
        const bool hg = u.pn < 8; bf16_t* base = hg ? phg : prw; const int ld = hg ? HGC : RWC; const int col0 = (hg ? u.pn : u.pn - 8) * 256 + wc * 32 + 8 * fq;
        float sv[8];
#pragma unroll
        for (int i = 0; i < 8; ++i) sv[i] = rs0[row0 + (i >> 2) * 128 + (i & 3) * 16];
#pragma unroll
        for (int ai = 0; ai < 2; ++ai)
#pragma unroll
            for (int m = 0; m < 4; ++m) {
                const int row = row0 + ai * 128 + m * 16; const float s = sv[ai * 4 + m]; bf16_t* rowp = base + (size_t)row * ld + col0;
#pragma unroll
                for (int bj = 0; bj < 2; ++bj) *(u32x4*)(rowp + bj * 128) = pack_acc8(acc[ai][bj][m][0], acc[ai][bj][m][1], s);
                if (!hg) {
                    bool last; float* dst;
                    if (row < NTOKP) { last = (row & 4095) == 4095; dst = psh + (row >> 12) * RWC; } else { const int rr = row - NTOKP; last = (rr & 31) == 31; dst = ssh + (rr >> 5) * RWC; }
                    if (last) {
#pragma unroll
                        for (int bj = 0; bj < 2; ++bj) { *(f32x4*)(dst + col0 + bj * 128) = acc[ai][bj][m][0] * s; *(f32x4*)(dst + col0 + bj * 128 + 4) = acc[ai][bj][m][1] * s; }
                    }
                }
            }
    }
};
struct EpiMemKV {
    static constexpr bool PERM = false;
    float* pmk; float* pmv; const float* rsm;
    __device__ __forceinline__ void operator()(const f32x4 (&acc)[2][2][4][2], const Unit& u, int wr, int wc, int fr, int fq) const {
        const int row0 = u.pm * 256 + wr * 64 + fr; const bool isk = u.pn < 4; float* base = isk ? pmk : pmv; const int col0 = (isk ? u.pn : u.pn - 4) * 256 + wc * 32 + 4 * fq;
        float sv[8];
#pragma unroll
        for (int i = 0; i < 8; ++i) sv[i] = rsm[row0 + (i >> 2) * 128 + (i & 3) * 16];
#pragma unroll
        for (int ai = 0; ai < 2; ++ai)
#pragma unroll
            for (int m = 0; m < 4; ++m) {
                const int row = row0 + ai * 128 + m * 16; const float s = sv[ai * 4 + m]; float* rowp = base + (size_t)row * D + col0;
#pragma unroll
                for (int bj = 0; bj < 2; ++bj)
#pragma unroll
                    for (int n = 0; n < 2; ++n) *(f32x4*)(rowp + bj * 128 + n * 16) = acc[ai][bj][m][n] * s;
            }
    }
};
struct EpiLora {
    static constexpr bool PERM = true;
    float* decay; bf16_t* kk; bf16_t* kka; bf16_t* kp; bf16_t* g; const bf16_t* xk; const float* kkn; const float* w0; const float* a0; const float* k_k; const float* k_a;
    __device__ __forceinline__ void operator()(const f32x4 (&acc)[2][2][4][2], const Unit& u, int wr, int wc, int fr, int fq) const {
        const int row0 = u.pm * 256 + wr * 64 + fr; const int type = u.pn >> 1; const int cb = (u.pn & 1) * 256 + wc * 32 + 8 * fq;
        if (type == 0) {
            float wv[2][8];
#pragma unroll
            for (int bj = 0; bj < 2; ++bj)
#pragma unroll
                for (int j = 0; j < 8; ++j) wv[bj][j] = w0[cb + bj * 128 + j];
#pragma unroll
            for (int ai = 0; ai < 2; ++ai)
#pragma unroll
                for (int m = 0; m < 4; ++m) {
                    const int row = row0 + ai * 128 + m * 16;
#pragma unroll
                    for (int bj = 0; bj < 2; ++bj) {
                        const size_t o = (size_t)row * 512 + cb + bj * 128; float d[8];
#pragma unroll
                        for (int j = 0; j < 8; ++j) { const float v = j < 4 ? acc[ai][bj][m][0][j] : acc[ai][bj][m][1][j - 4]; d[j] = __expf(-0.60653066f * sigmoidf_(wv[bj][j] + v)); }
                        *(f32x4*)(decay + o) = (f32x4){d[0], d[1], d[2], d[3]}; *(f32x4*)(decay + o + 4) = (f32x4){d[4], d[5], d[6], d[7]};
                    }
                }
        } else if (type == 1) {
#pragma unroll
            for (int ai = 0; ai < 2; ++ai)
#pragma unroll
                for (int mh = 0; mh < 2; ++mh) {
                    u32x4 xw[2][2]; float nr[2][2];
#pragma unroll
                    for (int m2 = 0; m2 < 2; ++m2) { const int row = row0 + ai * 128 + (mh * 2 + m2) * 16;
#pragma unroll
                        for (int bj = 0; bj < 2; ++bj) { xw[m2][bj] = *(const u32x4*)(xk + (size_t)row * 512 + cb + bj * 128); nr[m2][bj] = kkn[row * 8 + ((cb + bj * 128) >> 6)]; } }
#pragma unroll
                    for (int m2 = 0; m2 < 2; ++m2) { const int m = mh * 2 + m2; const int row = row0 + ai * 128 + m * 16;
#pragma unroll
                        for (int bj = 0; bj < 2; ++bj) {
                            const int c = cb + bj * 128; const size_t o = (size_t)row * 512 + c; float x[8], k1[8], k2[8], k3[8]; unpack8(xw[m2][bj], x);
#pragma unroll
                            for (int j = 0; j < 8; ++j) { const float v = j < 4 ? acc[ai][bj][m][0][j] : acc[ai][bj][m][1][j - 4]; const float a = sigmoidf_(a0[c + j] + v); const float kq = x[j] * k_k[c + j] * nr[m2][bj]; k1[j] = kq; k2[j] = kq * a; k3[j] = x[j] * (1.0f + (a - 1.0f) * k_a[c + j]); }
                            *(u32x4*)(kk + o) = pack8(k1); *(u32x4*)(kka + o) = pack8(k2); *(u32x4*)(kp + o) = pack8(k3);
                        } }
                }
        } else {
#pragma unroll
            for (int ai = 0; ai < 2; ++ai)
#pragma unroll
                for (int m = 0; m < 4; ++m) {
                    const int row = row0 + ai * 128 + m * 16;
#pragma unroll
                    for (int bj = 0; bj < 2; ++bj) *(u32x4*)(g + (size_t)row * 512 + cb + bj * 128) = pack_acc8(acc[ai][bj][m][0], acc[ai][bj][m][1], 1.0f);
                }
        }
    }
};
struct EpiRes {
    static constexpr bool PERM = false;
    const float* rp; const float* rs; float* out; bf16_t* xb; float* ssq;
    __device__ __forceinline__ void operator()(const f32x4 (&acc)[2][2][4][2], const Unit& u, int wr, int wc, int fr, int fq) const {
        const int row0 = u.pm * 256 + wr * 64 + fr; const int col0 = u.pn * 256 + wc * 32 + 4 * fq;
#pragma unroll
        for (int ai = 0; ai < 2; ++ai) {
            f32x4 rr[4][2][2];
#pragma unroll
            for (int m = 0; m < 4; ++m) {
                const int row = row0 + ai * 128 + m * 16;
                const float* rrow = (row < NTOKP ? rp + (size_t)row * D : rs + (size_t)(row - NTOKP) * D) + col0;
#pragma unroll
                for (int bj = 0; bj < 2; ++bj)
#pragma unroll
                    for (int n = 0; n < 2; ++n) rr[m][bj][n] = *(const f32x4*)(rrow + bj * 128 + n * 16);
            }
#pragma unroll
            for (int m = 0; m < 4; ++m) {
                const int row = row0 + ai * 128 + m * 16; float* orow = out + (size_t)row * D + col0; float ss = 0.f;
#pragma unroll
                for (int bj = 0; bj < 2; ++bj)
#pragma unroll
                    for (int n = 0; n < 2; ++n) {
                        const f32x4 x = rr[m][bj][n] + acc[ai][bj][m][n];
                        *(f32x4*)(orow + bj * 128 + n * 16) = x; ss += (x[0] * x[0] + x[1] * x[1]) + (x[2] * x[2] + x[3] * x[3]);
                        if (xb) { u32x2 w; w.x = cvt_pk_bf16(x[0], x[1]); w.y = cvt_pk_bf16(x[2], x[3]); *(u32x2*)(xb + (size_t)row * D + col0 + bj * 128 + n * 16) = w; }
                    }
                if (ssq) { ss += __shfl_xor(ss, 16); ss += __shfl_xor(ss, 32); if (fq == 0) ssq[row * 16 + u.pn * 4 + wc] = ss; }
            }
        }
    }
};
struct EpiQ {
    static constexpr bool PERM = true;
    bf16_t* q; const float* ssq;
    __device__ __forceinline__ void operator()(const f32x4 (&acc)[2][2][4][2], const Unit& u, int wr, int wc, int fr, int fq) const {
        const int row0 = u.pm * 256 + wr * 64 + fr; const int col0 = u.pn * 256 + wc * 32 + 8 * fq;
        float sv[8];
#pragma unroll
        for (int i = 0; i < 8; ++i) sv[i] = rs_from_parts4(ssq + (size_t)(row0 + (i >> 2) * 128 + (i & 3) * 16) * 16, fq) * 0.0625f;
#pragma unroll
        for (int ai = 0; ai < 2; ++ai)
#pragma unroll
            for (int m = 0; m < 4; ++m) {
                const int row = row0 + ai * 128 + m * 16; const float s = sv[ai * 4 + m]; bf16_t* rowp = q + (size_t)row * D + col0;
#pragma unroll
                for (int bj = 0; bj < 2; ++bj) *(u32x4*)(rowp + bj * 128) = pack_acc8(acc[ai][bj][m][0], acc[ai][bj][m][1], s);
            }
    }
};
struct EpiFF13 {
    static constexpr bool PERM = true;
    bf16_t* h; const float* ssq;
    __device__ __forceinline__ void operator()(const f32x4 (&acc)[2][2][4][2], const Unit& u, int wr, int wc, int fr, int fq) const {
        const int row0 = u.pm * 256 + wr * 64 + fr; const int col0 = u.pn * 128 + wc * 32 + 8 * fq;
        float sv[8];
#pragma unroll
        for (int i = 0; i < 8; ++i) sv[i] = rs_from_parts4(ssq + (size_t)(row0 + (i >> 2) * 128 + (i & 3) * 16) * 16, fq);
#pragma unroll
        for (int ai = 0; ai < 2; ++ai)
#pragma unroll
            for (int m = 0; m < 4; ++m) {
                const int row = row0 + ai * 128 + m * 16; const float s = sv[ai * 4 + m]; float o[8];
#pragma unroll
                for (int n = 0; n < 2; ++n)
#pragma unroll
                    for (int j = 0; j < 4; ++j) { const float a1 = acc[ai][0][m][n][j] * s, a3 = acc[ai][1][m][n][j] * s; o[n * 4 + j] = a1 * sigmoidf_(a1) * a3; }
                *(u32x4*)(h + (size_t)row * DFF + col0) = pack8(o);
            }
    }
};

template <int MODE>
__device__ __forceinline__ void sgemm_sample(LAS unsigned char* lds, const bf16_t* A, const bf16_t* Bt, int K, const float* resid, float* out, bf16_t* xb, float* ssq_out, const float* ssq_in) {
    const int tid = opaque_tid(), lane = tid & 63, w = __builtin_amdgcn_readfirstlane(tid >> 6), fr = lane & 15, fq = lane >> 4;
    const int u = blockIdx.x * 8 + w;
    const bool act = (gridDim.x == 256);
#pragma unroll 1
    for (int uu = u; uu < 2048; uu += gridDim.x * 8) {
        const int rt = uu >> 6, ct = uu & 63; const int row = NTOKP + rt * 16 + fr, col0 = ct * 16 + fq * 4;
        const bf16_t* ap = A + (size_t)row * K + fq * 8; const bf16_t* bp = Bt + (size_t)(ct * 16 + fr) * K + fq * 8;
        f32x4 acc = {0.f, 0.f, 0.f, 0.f};
#pragma unroll 8
        for (int ks = 0; ks < K / 32; ++ks) {
            const bf16x8 a = *(const bf16x8*)(ap + ks * 32); const bf16x8 b = *(const bf16x8*)(bp + ks * 32);
            acc = __builtin_amdgcn_mfma_f32_16x16x32_bf16(b, a, acc, 0, 0, 0);
        }
        if (MODE == 0) {
            const f32x4 x = *(const f32x4*)(resid + (size_t)(row - NTOKP) * D + col0) + acc;
            *(f32x4*)(out + (size_t)row * D + col0) = x;
            if (xb) { u32x2 wv; wv.x = cvt_pk_bf16(x[0], x[1]); wv.y = cvt_pk_bf16(x[2], x[3]); *(u32x2*)(xb + (size_t)row * D + col0) = wv; }
            if (ssq_out) {
                float ss = (x[0] * x[0] + x[1] * x[1]) + (x[2] * x[2] + x[3] * x[3]); ss += __shfl_xor(ss, 16); ss += __shfl_xor(ss, 32);
                if (fq == 0) *(LAS float*)(lds + (w * 16 + fr) * 4) = ss;
                __syncthreads();
                if (tid < 16) { float t = 0.f;
#pragma unroll
                    for (int i = 0; i < 8; ++i) t += *(const LAS float*)(lds + (i * 16 + tid) * 4);
                    const int g = (uu & 63) >> 3; float* sp = ssq_out + (size_t)(NTOKP + rt * 16 + tid) * 16; sp[g] = t; sp[8 + g] = 0.f; }
                __syncthreads();
            }
        } else {
            const float sc = rs_from_parts(ssq_in + (size_t)row * 16) * 0.0625f;
            u32x2 wv; wv.x = cvt_pk_bf16(acc[0] * sc, acc[1] * sc); wv.y = cvt_pk_bf16(acc[2] * sc, acc[3] * sc); *(u32x2*)(xb + (size_t)row * D + col0) = wv;
        }
    }
    (void)act;
    __syncthreads();
}

__device__ __forceinline__ void transpose_job(LAS float* tile, const float* src, int ldn, int K, int N, const float* gain, bf16_t* dst, int mode, int noff, int nbatch, size_t sstride, size_t dstride) {
    const int tid = opaque_tid(); const int tn = N / 64, tk = K / 64, per = tn * tk, total = per * nbatch;
    int t = blockIdx.x; if (t >= total) return;
    float v[8];
#define TR_LD(tt_) do { const int bb_ = (tt_) / per, t2_ = (tt_) % per; const int k0_ = (t2_ / tn) * 64, n0_ = (t2_ % tn) * 64; const float* s_ = src + (size_t)bb_ * sstride; \
        _Pragma("unroll") for (int i = 0; i < 8; ++i) { const int idx = tid + i * 512, kk = idx >> 6, nn = idx & 63; v[i] = s_[(size_t)(k0_ + kk) * ldn + n0_ + nn]; } \
        if (gain) { float g_[8]; _Pragma("unroll") for (int i = 0; i < 8; ++i) g_[i] = gain[k0_ + ((tid + i * 512) >> 6)]; _Pragma("unroll") for (int i = 0; i < 8; ++i) v[i] *= g_[i]; } } while (0)
    TR_LD(t);
#pragma unroll 1
    for (; t < total; t += gridDim.x) {
        const int bb = t / per, tt = t % per; const int k0 = (tt / tn) * 64, n0 = (tt % tn) * 64; bf16_t* d = dst + (size_t)bb * dstride;
#pragma unroll
        for (int i = 0; i < 8; ++i) { const int idx = tid + i * 512, kk = idx >> 6, nn = idx & 63; tile[kk * 65 + nn] = v[i]; }
        __syncthreads();
        if (t + (int)gridDim.x < total) TR_LD(t + (int)gridDim.x);
#pragma unroll
        for (int i = 0; i < 4; ++i) { const int idx = tid + i * 512, nn = idx >> 5, kp = idx & 31; const int n = n0 + nn;
            int r = n + noff; if (mode == 1) r = (n >> 7) * 256 + (n & 127); else if (mode == 2) r = (n >> 7) * 256 + 128 + (n & 127);
            *(unsigned*)(d + (size_t)r * K + k0 + 2 * kp) = cvt_pk_bf16(tile[(2 * kp) * 65 + nn], tile[(2 * kp + 1) * 65 + nn]); }
        __syncthreads();
    }
#undef TR_LD
}
__device__ __forceinline__ void transpose_wave(const float* src, int ldn, int K, int N, const float* gain, bf16_t* dst, int mode, int noff, int nbatch, size_t sstride, size_t dstride) {
    const int tid = opaque_tid(), lane = tid & 63, wid = tid >> 6; const int gw = blockIdx.x * 8 + wid, nw = gridDim.x * 8;
    const int tn = N / 64, tk = K / 64, per = tn * tk, total = per * nbatch;
#pragma unroll 1
    for (int t = gw; t < total; t += nw) {
        const int bb = t / per, tt = t - bb * per; const int k0 = (tt / tn) * 64, n0 = (tt % tn) * 64;
        const float* s_ = src + (size_t)bb * sstride + (size_t)k0 * ldn + n0 + lane; float v[64];
#pragma unroll
        for (int k = 0; k < 64; ++k) v[k] = s_[(size_t)k * ldn];
        if (gain) {
#pragma unroll
            for (int k = 0; k < 64; ++k) v[k] *= gain[k0 + k];
        }
        const int n = n0 + lane; int r = n + noff; if (mode == 1) r = (n >> 7) * 256 + (n & 127); else if (mode == 2) r = (n >> 7) * 256 + 128 + (n & 127);
        bf16_t* d = dst + (size_t)bb * dstride + (size_t)r * K + k0;
#pragma unroll
        for (int i = 0; i < 8; ++i) *(u32x4*)(d + i * 8) = pack8(v + i * 8);
    }
}
__device__ __forceinline__ void ph_prep(const Params& p, LAS unsigned char* lds) {
    const int tid = opaque_tid(), lane = tid & 63, wid = tid >> 6; const int gw = blockIdx.x * 8 + wid, nw = gridDim.x * 8;
    unsigned char* ws = p.ws;
    bf16_t* xb = (bf16_t*)(ws + WS_A); bf16_t* memb = (bf16_t*)(ws + WS_MEMB); float* rs0 = (float*)(ws + WS_RS0); float* rsm = (float*)(ws + WS_RSM);
    {
        const int TOT = NTOK + 2048; f32x4 cur[4], nxt[4];
#define RC_SRC(row) ((row) < NTOKP ? p.in[0] + (size_t)(row) * D : (row) < NTOK ? p.in[2] + (size_t)((row) - NTOKP) * D : p.in[1] + (size_t)((row) - NTOK) * D)
        int row = gw;
        if (row < TOT) { const f32x4* sp = (const f32x4*)RC_SRC(row);
#pragma unroll
            for (int i = 0; i < 4; ++i) cur[i] = sp[i * 64 + lane]; }
#pragma unroll 1
        for (; row < TOT; row += nw) {
            const int nr = row + nw;
            if (nr < TOT) { const f32x4* sp = (const f32x4*)RC_SRC(nr);
#pragma unroll
                for (int i = 0; i < 4; ++i) nxt[i] = sp[i * 64 + lane]; }
            float ss = 0.f;
#pragma unroll
            for (int i = 0; i < 4; ++i) ss += (cur[i][0] * cur[i][0] + cur[i][1] * cur[i][1]) + (cur[i][2] * cur[i][2] + cur[i][3] * cur[i][3]);
            ss = red64(ss);
            bf16_t* dstp = row < NTOK ? xb + (size_t)row * D : memb + (size_t)(row - NTOK) * D;
#pragma unroll
            for (int i = 0; i < 4; ++i) { u32x2 w2; w2.x = cvt_pk_bf16(cur[i][0], cur[i][1]); w2.y = cvt_pk_bf16(cur[i][2], cur[i][3]); ((u32x2*)dstp)[i * 64 + lane] = w2; }
            if (lane == 0) { if (row < NTOK) rs0[row] = rsqrtf(ss * (1.0f / 1024.0f) + 1e-6f); else rsm[row - NTOK] = rsqrtf(ss * (1.0f / 1024.0f) + 1e-6f); }
#pragma unroll
            for (int i = 0; i < 4; ++i) cur[i] = nxt[i];
        }
#undef RC_SRC
    }
    LAS float* tile = (LAS float*)lds;
#pragma unroll 1
    for (int job = 0; job < 9; ++job) {
        const float* src; const float* gain = nullptr; int ldn = 1024, K = 1024, N = 1024, mode = 0, noff = 0; size_t doff;
        switch (job) {
            case 0: src = p.in[10]; gain = p.in[9]; ldn = 3840; N = 3840; doff = WS_WIN; break;
            case 1: src = p.in[23]; doff = WS_WOUT; break;
            case 2: src = p.in[26]; gain = p.in[24]; doff = WS_WCQ; break;
            case 3: src = p.in[27]; gain = p.in[25]; doff = WS_WKV; break;
            case 4: src = p.in[28]; gain = p.in[25]; doff = WS_WKV; noff = 1024; break;
            case 5: src = p.in[29]; doff = WS_WCO; break;
            case 6: src = p.in[31]; gain = p.in[30]; ldn = 2816; N = 2816; mode = 1; doff = WS_WFF13; break;
            case 7: src = p.in[32]; gain = p.in[30]; ldn = 2816; N = 2816; mode = 2; doff = WS_WFF13; break;
            default: src = p.in[33]; K = 2816; doff = WS_WFF2; break;
        }
        transpose_job(tile, src, ldn, K, N, gain, (bf16_t*)(ws + doff), mode, noff, 1, 0, 0);
    }
    bf16_t* wl = (bf16_t*)(ws + WS_WLORA);
    for (int it = blockIdx.x * 512 + tid; it < 1536 * 32; it += gridDim.x * 512) {
        const int n = it % 1536, k0 = (it / 1536) * 8; const float* src = nullptr; int kb = 0, nn = n;
        if (n < 512) { if (k0 < 64) { src = p.in[14]; kb = k0; } }
        else if (n < 1024) { nn = n - 512; if (k0 >= 64 && k0 < 128) { src = p.in[16]; kb = k0 - 64; } }
        else { nn = n - 1024; if (k0 >= 128) { src = p.in[17]; kb = k0 - 128; } }
        float v[8];
#pragma unroll
        for (int j = 0; j < 8; ++j) v[j] = 0.f;
        if (src) {
#pragma unroll
            for (int j = 0; j < 8; ++j) v[j] = src[(kb + j) * 512 + nn];
        }
        *(u32x4*)(wl + (size_t)n * 256 + k0) = pack8(v);
    }
}

__device__ __forceinline__ void ph_rwprep(const Params& p) {
    const int tid = opaque_tid(), lane = tid & 63, wid = tid >> 6; const int gw = blockIdx.x * 8 + wid, nw = gridDim.x * 8;
    unsigned char* ws = p.ws;
    const bf16_t* prw = (const bf16_t*)(ws + WS_PRW);
    bf16_t* rb = (bf16_t*)(ws + WS_A); bf16_t* vb = (bf16_t*)(ws + WS_A + HALF512);
    bf16_t* al = (bf16_t*)(ws + WS_B); bf16_t* xk = (bf16_t*)(ws + WS_B + 17039360);
    float* kkn = (float*)(ws + WS_KKN);
    const float* mu = p.in[12]; const float* k_k = p.in[18];
    float mu8[3][8], mul[4], kk8[8];
#pragma unroll
    for (int i = 0; i < 3; ++i)
#pragma unroll
        for (int j = 0; j < 8; ++j) mu8[i][j] = mu[i * 512 + lane * 8 + j];
#pragma unroll
    for (int j = 0; j < 4; ++j) mul[j] = mu[1536 + lane * 4 + j];
#pragma unroll
    for (int j = 0; j < 8; ++j) kk8[j] = k_k[lane * 8 + j];
#pragma unroll 1
    for (int row = gw; row < NTOK; row += nw) {
        const float* sh = nullptr; bool first;
        if (row < NTOKP) first = (row & 4095) == 0; else { const int rr = row - NTOKP; first = (rr & 31) == 0; sh = p.in[7] + (size_t)(rr >> 5) * RWC; }
        const bf16_t* cur = prw + (size_t)row * RWC; const bf16_t* prv = first ? cur : cur - RWC;
        u32x4 cw[3], pw[3];
#pragma unroll
        for (int i = 0; i < 3; ++i) { cw[i] = *(const u32x4*)(cur + i * 512 + lane * 8); pw[i] = *(const u32x4*)(prv + i * 512 + lane * 8); }
        const u32x2 cl = *(const u32x2*)(cur + 1536 + lane * 4), pl = *(const u32x2*)(prv + 1536 + lane * 4);
        float pvf[3][8], plf[4];
#pragma unroll
        for (int i = 0; i < 3; ++i) unpack8(pw[i], pvf[i]);
        plf[0] = bf_lo(pl.x); plf[1] = bf_hi(pl.x); plf[2] = bf_lo(pl.y); plf[3] = bf_hi(pl.y);
        if (first) {
            if (sh) {
#pragma unroll
                for (int i = 0; i < 3; ++i) { const f32x4 a = *(const f32x4*)(sh + i * 512 + lane * 8), b2 = *(const f32x4*)(sh + i * 512 + lane * 8 + 4);
                    pvf[i][0] = a[0]; pvf[i][1] = a[1]; pvf[i][2] = a[2]; pvf[i][3] = a[3]; pvf[i][4] = b2[0]; pvf[i][5] = b2[1]; pvf[i][6] = b2[2]; pvf[i][7] = b2[3]; }
                const f32x4 a = *(const f32x4*)(sh + 1536 + lane * 4); plf[0] = a[0]; plf[1] = a[1]; plf[2] = a[2]; plf[3] = a[3];
            } else {
#pragma unroll
                for (int i = 0; i < 3; ++i)
#pragma unroll
                    for (int j = 0; j < 8; ++j) pvf[i][j] = 0.f;
                plf[0] = plf[1] = plf[2] = plf[3] = 0.f;
            }
        }
        const size_t o = (size_t)row * 512 + lane * 8;
#pragma unroll
        for (int i = 0; i < 3; ++i) {
            float c[8], x[8]; unpack8(cw[i], c);
#pragma unroll
            for (int j = 0; j < 8; ++j) x[j] = c[j] + (pvf[i][j] - c[j]) * mu8[i][j];
            if (i == 0) *(u32x4*)(rb + o) = pack8(x);
            else if (i == 2) *(u32x4*)(vb + o) = pack8(x);
            else {
                *(u32x4*)(xk + o) = pack8(x); float ss = 0.f;
#pragma unroll
                for (int j = 0; j < 8; ++j) { const float kv = x[j] * kk8[j]; ss += kv * kv; }
                ss = red8(ss);
                if ((lane & 7) == 0) kkn[row * 8 + (lane >> 3)] = 1.0f / fmaxf(sqrtf(ss), 1e-12f);
            }
        }
        {
            const float c[4] = {bf_lo(cl.x), bf_hi(cl.x), bf_lo(cl.y), bf_hi(cl.y)}; float x[4];
#pragma unroll
            for (int j = 0; j < 4; ++j) { float t = c[j] + (plf[j] - c[j]) * mul[j]; if (lane < 16) t = 1.0f - 2.0f * __builtin_amdgcn_rcpf(__expf(2.0f * t) + 1.0f); else if (lane >= 32) t = sigmoidf_(t); x[j] = t; }
            u32x2 w; w.x = cvt_pk_bf16(x[0], x[1]); w.y = cvt_pk_bf16(x[2], x[3]); *(u32x2*)(al + (size_t)row * 256 + lane * 4) = w;
        }
    }
}
__device__ __forceinline__ void ph_kvconv(const Params& p, LAS unsigned char* lds) {
    const int tid = opaque_tid(); unsigned char* ws = p.ws; bf16_t* kb = (bf16_t*)(ws + WS_KB); bf16_t* vt = (bf16_t*)(ws + WS_VT);
    const size_t per = 256 * 1024;
    {
        const size_t nvec = 24 * per / 4, stride = (size_t)gridDim.x * 512;
        for (size_t i0 = (size_t)blockIdx.x * 512 + tid; i0 < nvec; i0 += 4 * stride) {
            f32x4 v[4];
#pragma unroll
            for (int j = 0; j < 4; ++j) { const size_t i = i0 + j * stride; if (i < nvec) { const size_t e = i * 4; const int b = (int)(e / per); const size_t off = e % per;
                const float* src = b < 8 ? p.out + O_PMK + (size_t)b * per + off : p.in[3] + (size_t)(b - 8) * per + off; v[j] = *(const f32x4*)src; } }
#pragma unroll
            for (int j = 0; j < 4; ++j) { const size_t i = i0 + j * stride; if (i < nvec) { u32x2 w; w.x = cvt_pk_bf16(v[j][0], v[j][1]); w.y = cvt_pk_bf16(v[j][2], v[j][3]); *(u32x2*)(kb + i * 4) = w; } }
        }
    }
    LAS float* tile = (LAS float*)lds;
#pragma unroll 1
    for (int job = 0; job < 2; ++job) {
        const float* src = job ? p.in[4] : p.out + O_PMV; bf16_t* dst = job ? vt + 8 * per : vt; const int nb = job ? 16 : 8;
        transpose_job(tile, src, 1024, 256, 1024, nullptr, dst, 0, 0, nb, per, per);
    }
}

struct RwStep { f32x4 d, k, a, p, r; float v; };
__device__ __forceinline__ void rwkv_scan(const Params& p, LAS unsigned char* lds, int rowbase, int T, int h, int q4, const float* S0, float* Sout) {
    const int tid = opaque_tid(), lane = tid & 63, w = __builtin_amdgcn_readfirstlane(tid >> 6), rowl = lane >> 4, seg = lane & 15; const int vloc = (w & 3) * 4 + rowl, vrow = q4 * 16 + vloc;
    unsigned char* ws = p.ws;
    const float* decay = p.out; const bf16_t* kk = (const bf16_t*)((const unsigned char*)p.out + 68157440); const bf16_t* kka = (const bf16_t*)((const unsigned char*)p.out + 68157440 + HALF512);
    const bf16_t* kp = (const bf16_t*)(ws + WS_PRW); const bf16_t* rb = (const bf16_t*)(ws + WS_A); const bf16_t* vb = (const bf16_t*)(ws + WS_A + HALF512);
    bf16_t* ob = (bf16_t*)(ws + WS_B);
    const bool comp = w < 4;
    f32x4 S = (f32x4){0.f, 0.f, 0.f, 0.f};
    if (comp && S0) S = *(const f32x4*)(S0 + vrow * 64 + seg * 4);
    constexpr int BUF = 43008;
    const int lstep = tid >> 4, lj = tid & 15;
    f32x4 gd; u32x2 gk, ga, gp, gr, gv;
    auto gload = [&](int c) {
        const size_t o = (size_t)(rowbase + c * 32 + lstep) * 512 + h * 64 + lj * 4;
        gd = *(const f32x4*)(decay + o); gk = *(const u32x2*)(kk + o); ga = *(const u32x2*)(kka + o); gp = *(const u32x2*)(kp + o); gr = *(const u32x2*)(rb + o);
        if (lj < 4) gv = *(const u32x2*)(vb + (size_t)(rowbase + c * 32 + lstep) * 512 + h * 64 + q4 * 16 + lj * 4);
    };
    auto up4 = [](const u32x2 x) { return (f32x4){bf_lo(x.x), bf_hi(x.x), bf_lo(x.y), bf_hi(x.y)}; };
    float selv[16];
#pragma unroll
    for (int i = 0; i < 16; ++i) selv[i] = (seg == i) ? 1.0f : 0.0f;
    const int nch = T / 32;
    gload(0);
#pragma unroll 1
    for (int c = 0; c < nch; ++c) {
        LAS unsigned char* b = lds + (c & 1) * BUF;
        *(LAS f32x4*)(b + lstep * 256 + lj * 16) = gd;
        *(LAS f32x4*)(b + 8192 + lstep * 256 + lj * 16) = up4(gk);
        *(LAS f32x4*)(b + 16384 + lstep * 256 + lj * 16) = up4(ga);
        *(LAS f32x4*)(b + 24576 + lstep * 256 + lj * 16) = up4(gp);
        *(LAS f32x4*)(b + 32768 + lstep * 256 + lj * 16) = up4(gr);
        if (lj < 4) *(LAS f32x4*)(b + 40960 + lstep * 64 + lj * 16) = up4(gv);
        __syncthreads();
        if (c + 1 < nch) gload(c + 1);
        if (comp) {
            const LAS unsigned char* bs = b + seg * 16; const LAS unsigned char* bv = b + 40960 + vloc * 4;
#define RW_LD(X, s) do { X.d = *(const LAS f32x4*)(bs + (s) * 256); X.k = *(const LAS f32x4*)(bs + 8192 + (s) * 256); X.a = *(const LAS f32x4*)(bs + 16384 + (s) * 256); \
                         X.p = *(const LAS f32x4*)(bs + 24576 + (s) * 256); X.r = *(const LAS f32x4*)(bs + 32768 + (s) * 256); X.v = *(const LAS float*)(bv + (s) * 64); } while (0)
#define RW_STEP(X, s) do { float sa = fmaf(S[3], X.k[3], fmaf(S[2], X.k[2], fmaf(S[1], X.k[1], S[0] * X.k[0]))); const f32x4 T = S * X.d + X.v * X.p; sa = -red16(sa); \
                           S = T + sa * X.a; float y = fmaf(S[3], X.r[3], fmaf(S[2], X.r[2], fmaf(S[1], X.r[1], S[0] * X.r[0]))); y = red16(y); \
                           yk = fmaf(selv[(s) & 15], y, yk); } while (0)
            RwStep xa, xb, xc; float yk = 0.f;
#define RW_YST(s) do { if ((s) == 15) { ob[(size_t)(rowbase + c * 32 + seg) * D + 512 + h * 64 + vrow] = f2bf(yk); yk = 0.f; } } while (0)
            RW_LD(xa, 0); RW_LD(xb, 1);
#pragma unroll
            for (int s = 0; s < 30; s += 3) {
                RW_LD(xc, s + 2); RW_STEP(xa, s); RW_YST(s);
                RW_LD(xa, s + 3); RW_STEP(xb, s + 1); RW_YST(s + 1);
                RW_LD(xb, s + 4); RW_STEP(xc, s + 2); RW_YST(s + 2);
            }
            RW_STEP(xa, 30); RW_STEP(xb, 31);
            ob[(size_t)(rowbase + c * 32 + 16 + seg) * D + 512 + h * 64 + vrow] = f2bf(yk);
#undef RW_YST
#undef RW_LD
#undef RW_STEP
        }
    }
    if (comp) *(f32x4*)(Sout + vrow * 64 + seg * 4) = S;
    __syncthreads();
}

__device__ __forceinline__ void hg_prep_chunk(const Params& p, LAS unsigned char* lds, int task) {
    const int tid = opaque_tid(), lane = tid & 63, w = __builtin_amdgcn_readfirstlane(tid >> 6), fr = lane & 15, fq = lane >> 4;
    unsigned char* ws = p.ws; bf16_t* phg = (bf16_t*)(ws + WS_PHG); bf16_t* oi = (bf16_t*)(ws + WS_OI); float* decb = (float*)(ws + WS_DECB);
    constexpr int QG = 0, KG = 17408, VT = 34816, ATT = 53248, SEG = 62464;
    int row0, TC, h;
    if (task < 2048) { const int seq = task >> 6, ch = task & 63; h = seq & 3; row0 = (seq >> 2) * 4096 + ch * 64; TC = 64; }
    else { const int s = task - 2048; h = s & 3; row0 = NTOKP + (s >> 2) * 32; TC = 32; }
    const int c = tid & 127, sg = tid >> 7;
    const float l0 = p.in[8][h * 128 + c], l1 = p.in[8][512 + h * 128 + c]; const float lb = 1.0f / (1.0f + __expf(l1 - l0)), omlb = 1.0f - lb;
    const bool valid = sg * 16 < TC;
    float cp[16], kx[16], qv[16], vv[16]; float run = 1.f;
    {
        const bf16_t* rp = phg + (size_t)(row0 + (valid ? sg * 16 : 0)) * HGC + h * 128 + c; bf16_t rq[16], rf[16], rv[16];
#pragma unroll
        for (int j = 0; j < 16; ++j) { rq[j] = rp[(size_t)j * HGC]; rf[j] = rp[(size_t)j * HGC + 512]; rv[j] = rp[(size_t)j * HGC + 1024]; }
#pragma unroll
        for (int j = 0; j < 16; ++j) {
            const float sgm = sigmoidf_(bf1(rf[j])); const float f = valid ? lb + omlb * sgm : 1.0f; run *= f; cp[j] = run;
            kx[j] = valid ? omlb * (1.0f - sgm) : 0.f; qv[j] = valid ? bf1(rq[j]) : 0.f; vv[j] = valid ? bf1(rv[j]) : 0.f;
        }
    }
    *(LAS float*)(lds + SEG + (sg * 128 + c) * 4) = run;
    __syncthreads();
    float pre = 1.f, tot = 1.f;
#pragma unroll
    for (int s2 = 0; s2 < 4; ++s2) { const float x = *(const LAS float*)(lds + SEG + (s2 * 128 + c) * 4); tot *= x; if (s2 < sg) pre *= x; }
    {
        float kd[16];
#pragma unroll
        for (int j = 0; j < 16; ++j) {
            const float P = pre * cp[j]; const int t = sg * 16 + j; const float qg = qv[j] * P, kg = kx[j] * __builtin_amdgcn_rcpf(P);
            const bf16_t qgb = f2bf(qg);
            *(LAS bf16_t*)(lds + QG + t * 272 + c * 2) = qgb;
            *(LAS bf16_t*)(lds + KG + t * 272 + c * 2) = f2bf(kg);
            kd[j] = kg * tot;
            if (valid) phg[(size_t)(row0 + t) * HGC + h * 128 + c] = qgb;
        }
        const u32x4 v0 = pack8(vv), v1 = pack8(vv + 8);
        *(LAS u32x4*)(lds + VT + c * 144 + sg * 32) = v0; *(LAS u32x4*)(lds + VT + c * 144 + sg * 32 + 16) = v1;
        if (valid) {
            const int lin = c * TC + sg * 16; bf16_t* dst = phg + (size_t)(row0 + (lin >> 7)) * HGC + h * 128 + (lin & 127);
            *(u32x4*)(dst + 512) = pack8(kd); *(u32x4*)(dst + 512 + 8) = pack8(kd + 8);
            *(u32x4*)(dst + 1024) = v0; *(u32x4*)(dst + 1024 + 8) = v1;
        }
        if (sg == 0) decb[task * 128 + c] = tot;
    }
    __syncthreads();
    {
        const int tt = w >> 1;
#pragma unroll
        for (int q2 = 0; q2 < 2; ++q2) {
            const int st = 2 * (w & 1) + q2; f32x4 a = {0.f, 0.f, 0.f, 0.f};
#pragma unroll
            for (int ks = 0; ks < 4; ++ks) {
                const bf16x8 kf = *(const LAS bf16x8*)(lds + KG + (st * 16 + fr) * 272 + (ks * 32 + fq * 8) * 2);
                const bf16x8 qf = *(const LAS bf16x8*)(lds + QG + (tt * 16 + fr) * 272 + (ks * 32 + fq * 8) * 2);
                a = __builtin_amdgcn_mfma_f32_16x16x32_bf16(kf, qf, a, 0, 0, 0);
            }
            const int t = tt * 16 + fr; float m[4];
#pragma unroll
            for (int j = 0; j < 4; ++j) { const int s = st * 16 + fq * 4 + j; m[j] = (s <= t) ? a[j] : 0.f; }
            u32x2 wv; wv.x = cvt_pk_bf16(m[0], m[1]); wv.y = cvt_pk_bf16(m[2], m[3]);
            *(LAS u32x2*)(lds + ATT + t * 144 + (st * 16 + fq * 4) * 2) = wv;
        }
    }
    __syncthreads();
#pragma unroll
    for (int tt = 0; tt < 4; ++tt) {
        f32x4 a = {0.f, 0.f, 0.f, 0.f};
#pragma unroll
        for (int ks = 0; ks < 2; ++ks) {
            const bf16x8 vf = *(const LAS bf16x8*)(lds + VT + (w * 16 + fr) * 144 + (ks * 32 + fq * 8) * 2);
            const bf16x8 af = *(const LAS bf16x8*)(lds + ATT + (tt * 16 + fr) * 144 + (ks * 32 + fq * 8) * 2);
            a = __builtin_amdgcn_mfma_f32_16x16x32_bf16(vf, af, a, 0, 0, 0);
        }
        const int t = tt * 16 + fr;
        if (t < TC) { u32x2 wv; wv.x = cvt_pk_bf16(a[0], a[1]); wv.y = cvt_pk_bf16(a[2], a[3]); *(u32x2*)(oi + ((size_t)(h * 4 + (w >> 1)) * NTOK + row0 + t) * 32 + (w & 1) * 16 + fq * 4) = wv; }
    }
    __syncthreads();
}
__device__ __forceinline__ void ph_hgprep(const Params& p, LAS unsigned char* lds) {
#pragma unroll 1
    for (int t = blockIdx.x; t < 2112; t += gridDim.x) hg_prep_chunk(p, lds, t);
}
__device__ __forceinline__ void hg_seq(const Params& p, LAS unsigned char* lds, int task) {
    const int tid = opaque_tid(), lane = tid & 63, w = __builtin_amdgcn_readfirstlane(tid >> 6), fr = lane & 15, fq = lane >> 4;
    unsigned char* ws = p.ws; const bf16_t* phg = (const bf16_t*)(ws + WS_PHG); const bf16_t* oi = (const bf16_t*)(ws + WS_OI); const float* decb = (const float*)(ws + WS_DECB); bf16_t* ob = (bf16_t*)(ws + WS_B);
    constexpr int QG = 0, KDT = 17408, VT = 35840, ST = 40448;
    int rowbase, TC, h, vq, nch, dbase; const float* S0 = nullptr; float* Sout;
    if (task < 128) { const int b = task >> 4; h = (task >> 2) & 3; vq = task & 3; rowbase = b * 4096; TC = 64; nch = 64; dbase = (b * 4 + h) * 64; Sout = p.out + O_PHG + (size_t)(b * 4 + h) * 16384; }
    else { const int s = task - 128, b = s >> 4; h = (s >> 2) & 3; vq = s & 3; rowbase = NTOKP + b * 32; TC = 32; nch = 1; dbase = 2048 + b * 4 + h; S0 = p.in[5] + (size_t)(b * 4 + h) * 16384; Sout = p.out + O_SHG + (size_t)(b * 4 + h) * 16384; }
    f32x4 S[2];
#pragma unroll
    for (int vt = 0; vt < 2; ++vt)
#pragma unroll
        for (int j = 0; j < 4; ++j) S[vt][j] = S0 ? S0[(w * 16 + fq * 4 + j) * 128 + vq * 32 + vt * 16 + fr] : 0.f;
    const int tt = w >> 1, vt_o = w & 1;
    const int prow = tid >> 4, pcol = tid & 15;
    struct HgR { u32x4 gq[2], gk[2], gv; u32x2 go; f32x4 gdec; };
    auto gload = [&](HgR& R, int ch) {
        const int row0 = rowbase + ch * 64;
#pragma unroll
        for (int j = 0; j < 2; ++j) {
            const int r = prow + j * 32; const bool ok = r < TC;
            const bf16_t* src = phg + (size_t)(row0 + (ok ? r : 0)) * HGC + h * 128 + pcol * 8;
            R.gq[j] = *(const u32x4*)src; R.gk[j] = *(const u32x4*)(src + 512);
        }
        if (tid < 256) {
            const int r = tid >> 4; const bool ok = r < (TC >> 2);
            const bf16_t* src = phg + (size_t)(row0 + ((vq * 32 * TC) >> 7) + (ok ? r : 0)) * HGC + 1024 + h * 128 + pcol * 8;
            R.gv = *(const u32x4*)src;
        }
        { const int t = tt * 16 + fr; const bool ok = t < TC; R.go = *(const u32x2*)(oi + ((size_t)(h * 4 + vq) * NTOK + row0 + (ok ? t : 0)) * 32 + vt_o * 16 + fq * 4); }
        R.gdec = *(const f32x4*)(decb + (size_t)(dbase + ch) * 128 + w * 16 + fq * 4);
    };
    HgR ra, rb;
    gload(ra, 0); if (nch > 1) gload(rb, 1);
    auto body = [&](HgR& R, int ch) {
        const int row0 = rowbase + ch * 64;
#pragma unroll
        for (int j = 0; j < 2; ++j) {
            const int r = prow + j * 32; const u32x4 z4 = (u32x4){0u, 0u, 0u, 0u};
            *(LAS u32x4*)(lds + QG + r * 272 + pcol * 16) = (r < TC) ? R.gq[j] : z4;
            if (TC == 64) { const int lin = r * 128 + pcol * 8; *(LAS u32x4*)(lds + KDT + (lin >> 6) * 144 + (lin & 63) * 2) = R.gk[j]; }
            else if (r < 32) { const int lin = r * 128 + pcol * 8; *(LAS u32x4*)(lds + KDT + (lin >> 5) * 144 + (lin & 31) * 2) = R.gk[j]; }
        }
        if (TC == 32 && tid < 256) {
#pragma unroll
            for (int j = 0; j < 2; ++j) { const int i2 = tid + j * 256; *(LAS u32x4*)(lds + KDT + (i2 >> 2) * 144 + 64 + (i2 & 3) * 16) = (u32x4){0u, 0u, 0u, 0u}; }
        }
        if (tid < 256) {
            const int r = tid >> 4; const int lin = r * 128 + pcol * 8;
            if (TC == 64) *(LAS u32x4*)(lds + VT + (lin >> 6) * 144 + (lin & 63) * 2) = R.gv;
            else { if (r < 8) *(LAS u32x4*)(lds + VT + (lin >> 5) * 144 + (lin & 31) * 2) = R.gv;
                   *(LAS u32x4*)(lds + VT + (tid >> 3) * 144 + 64 + (tid & 3) * 16 + ((tid >> 2) & 1) * 0) = (u32x4){0u, 0u, 0u, 0u}; }
        }
#pragma unroll
        for (int vt = 0; vt < 2; ++vt) { u32x2 wv; wv.x = cvt_pk_bf16(S[vt][0], S[vt][1]); wv.y = cvt_pk_bf16(S[vt][2], S[vt][3]); *(LAS u32x2*)(lds + ST + (vt * 16 + fr) * 272 + (w * 16 + fq * 4) * 2) = wv; }
        const float oi0 = bf_lo(R.go.x), oi1 = bf_hi(R.go.x), oi2 = bf_lo(R.go.y), oi3 = bf_hi(R.go.y);
        S[0] = S[0] * R.gdec; S[1] = S[1] * R.gdec;
        __syncthreads();
        if (ch + 2 < nch) gload(R, ch + 2);
        {
            f32x4 a = {0.f, 0.f, 0.f, 0.f};
#pragma unroll
            for (int ks = 0; ks < 4; ++ks) {
                const bf16x8 sf = *(const LAS bf16x8*)(lds + ST + (vt_o * 16 + fr) * 272 + (ks * 32 + fq * 8) * 2);
                const bf16x8 qf = *(const LAS bf16x8*)(lds + QG + (tt * 16 + fr) * 272 + (ks * 32 + fq * 8) * 2);
                a = __builtin_amdgcn_mfma_f32_16x16x32_bf16(sf, qf, a, 0, 0, 0);
            }
            const int t = tt * 16 + fr;
            if (t < TC) {
                u32x2 wv; wv.x = cvt_pk_bf16(a[0] + oi0, a[1] + oi1); wv.y = cvt_pk_bf16(a[2] + oi2, a[3] + oi3);
                *(u32x2*)((bf16_t*)oi + ((size_t)(h * 4 + vq) * NTOK + row0 + t) * 32 + vt_o * 16 + fq * 4) = wv;
            }
        }
#pragma unroll
        for (int vt = 0; vt < 2; ++vt) {
#pragma unroll
            for (int ks = 0; ks < 2; ++ks) {
                const bf16x8 kf = *(const LAS bf16x8*)(lds + KDT + (w * 16 + fr) * 144 + (ks * 32 + fq * 8) * 2);
                const bf16x8 vf = *(const LAS bf16x8*)(lds + VT + (vt * 16 + fr) * 144 + (ks * 32 + fq * 8) * 2);
                S[vt] = __builtin_amdgcn_mfma_f32_16x16x32_bf16(kf, vf, S[vt], 0, 0, 0);
            }
        }
        __syncthreads();
    };
#pragma unroll 1
    for (int ch = 0; ch < nch; ch += 2) { body(ra, ch); if (ch + 1 < nch) body(rb, ch + 1); }
#pragma unroll
    for (int vt = 0; vt < 2; ++vt)
#pragma unroll
        for (int j = 0; j < 4; ++j) Sout[(w * 16 + fq * 4 + j) * 128 + vq * 32 + vt * 16 + fr] = S[vt][j];
}
__device__ __forceinline__ void ph_hgseq(const Params& p, LAS unsigned char* lds, int first, int nblk) {
#pragma unroll 1
    for (int t = (int)blockIdx.x - first; t < 384; t += nblk) hg_seq(p, lds, t);
}
__device__ __forceinline__ void ph_scan(const Params& p, LAS unsigned char* lds) {
#pragma unroll 1
    for (int task = blockIdx.x; task < 768; task += gridDim.x) {
        if (task < 256) { const int b = task >> 5, h = (task >> 2) & 7, q4 = task & 3; rwkv_scan(p, lds, b * 4096, 4096, h, q4, nullptr, p.out + O_PRW + (size_t)(b * 8 + h) * 4096); }
        else { const int t = task - 256, b = t >> 5, h = (t >> 2) & 7, q4 = t & 3; rwkv_scan(p, lds, NTOKP + b * 32, 32, h, q4, p.in[6] + (size_t)(b * 8 + h) * 4096, p.out + O_SRW + (size_t)(b * 8 + h) * 4096); }
    }
}

__device__ __forceinline__ void ph_rwpost(const Params& p) {
    const int tid = opaque_tid(), lane = tid & 63, wid = tid >> 6; const int gw = blockIdx.x * 8 + wid, nw = gridDim.x * 8;
    unsigned char* ws = p.ws; bf16_t* ob = (bf16_t*)(ws + WS_B); const bf16_t* phg = (const bf16_t*)(ws + WS_PHG); const bf16_t* oi = (const bf16_t*)(ws + WS_OI);
    const bf16_t* kp = (const bf16_t*)(ws + WS_PRW); const bf16_t* gb = (const bf16_t*)(ws + WS_PRW + HALF512); const bf16_t* rb = (const bf16_t*)(ws + WS_A); const bf16_t* vb = (const bf16_t*)(ws + WS_A + HALF512);
    const int c = lane * 8; float rk[8], gw8[8], gb8[8], hn[8];
#pragma unroll
    for (int j = 0; j < 8; ++j) { rk[j] = p.in[20][c + j]; gw8[j] = p.in[21][c + j]; gb8[j] = p.in[22][c + j]; hn[j] = p.in[11][c + j]; }
    u32x4 cur[7], nxt[7];
#define RP_LD(X, row) do { const size_t o_ = (size_t)(row) * 512 + c; X[0] = *(const u32x4*)(ob + (size_t)(row) * D + 512 + c); X[1] = *(const u32x4*)(rb + o_); X[2] = *(const u32x4*)(kp + o_); \
        X[3] = *(const u32x4*)(vb + o_); X[4] = *(const u32x4*)(gb + o_); X[5] = *(const u32x4*)(oi + ((size_t)(c >> 5) * NTOK + (row)) * 32 + (c & 31)); X[6] = *(const u32x4*)(phg + (size_t)(row) * HGC + 1536 + c); } while (0)
    int row = gw;
    if (row < NTOK) RP_LD(cur, row);
#pragma unroll 1
    for (; row < NTOK; row += nw) {
        const int nr = row + nw;
        if (nr < NTOK) RP_LD(nxt, nr);
        float y[8], r[8], k[8], v[8], g[8], ho[8], hg[8];
        unpack8(cur[0], y); unpack8(cur[1], r); unpack8(cur[2], k); unpack8(cur[3], v); unpack8(cur[4], g); unpack8(cur[5], ho); unpack8(cur[6], hg);
        float s = 0.f, bs = 0.f, hs = 0.f;
#pragma unroll
        for (int j = 0; j < 8; ++j) { s += y[j]; bs += r[j] * k[j] * rk[j]; hs += ho[j] * ho[j]; }
        s = red8(s); bs = red8(bs); hs = red16(hs); const float mean = s * (1.0f / 64.0f); float q = 0.f;
#pragma unroll
        for (int j = 0; j < 8; ++j) { const float d = y[j] - mean; q += d * d; }
        q = red8(q); const float rstd = rsqrtf(q * (1.0f / 64.0f) + 64e-5f); const float hrs = rsqrtf(hs * (1.0f / 128.0f) + 1e-6f); float out[8], hout[8];
#pragma unroll
        for (int j = 0; j < 8; ++j) { out[j] = ((y[j] - mean) * rstd * gw8[j] + gb8[j] + bs * v[j]) * g[j]; hout[j] = ho[j] * hrs * hn[j] * (hg[j] * sigmoidf_(hg[j])); }
        *(u32x4*)(ob + (size_t)row * D + 512 + c) = pack8(out);
        *(u32x4*)(ob + (size_t)row * D + c) = pack8(hout);
#pragma unroll
        for (int i = 0; i < 7; ++i) cur[i] = nxt[i];
    }
#undef RP_LD
}

__device__ __forceinline__ void ph_attn(const Params& p, LAS unsigned char* lds) {
    const int tid = opaque_tid(), lane = tid & 63, w = __builtin_amdgcn_readfirstlane(tid >> 6), fr = lane & 15, fq = lane >> 4;
    unsigned char* ws = p.ws; const bf16_t* qb = (const bf16_t*)(ws + WS_A); const bf16_t* kb = (const bf16_t*)(ws + WS_KB); const bf16_t* vt = (const bf16_t*)(ws + WS_VT); bf16_t* ao = (bf16_t*)(ws + WS_B);
    constexpr int PR = 36864;
    LAS unsigned char* pw = lds + PR + w * 8448 + fr * 528 + fq * 8;
    const unsigned koff = (unsigned)((tid >> 5) * 1024 + (tid & 31) * 8);
    const unsigned voff = (unsigned)((tid >> 3) * 256 + (tid & 7) * 8);
    LAS unsigned char* kst = lds + (tid >> 5) * 528 + (tid & 31) * 16;
    LAS unsigned char* vst = lds + (tid >> 3) * 144 + (tid & 7) * 16;
    const LAS unsigned char* krd = lds + fr * 528 + fq * 16;
    const LAS unsigned char* vrd = lds + fr * 144 + fq * 16;
#pragma unroll 1
    for (int u = blockIdx.x; u < 1088; u += gridDim.x) {
        int r0, nrows, kvb, h;
        if (u < 1024) { const int tile = u >> 2; h = u & 3; r0 = tile * 128; nrows = 128; kvb = tile >> 5; }
        else { const int s = u - 1024, b = s >> 2; h = s & 3; r0 = NTOKP + b * 32; nrows = 32; kvb = 8 + b; }
        const bool active = (w * 16) < nrows;
        bf16x8 qf[8];
        if (active) {
            const bf16_t* qp = qb + (size_t)(r0 + w * 16 + fr) * D + h * 256 + fq * 8;
#pragma unroll
            for (int ks = 0; ks < 8; ++ks) qf[ks] = *(const bf16x8*)(qp + ks * 32);
        }
        u32x4 st[4];
        const bf16_t* kbase = kb + (size_t)kvb * 256 * 1024 + h * 256; const bf16_t* vbase = vt + ((size_t)kvb * 1024 + h * 256) * 256;
#define LOADK(i) do { _Pragma("unroll") for (int j = 0; j < 4; ++j) st[j] = *(const u32x4*)(kbase + ((i) * 64 + j * 16) * 1024 + koff); } while (0)
#define LOADV(i) do { _Pragma("unroll") for (int j = 0; j < 4; ++j) st[j] = *(const u32x4*)(vbase + (j * 64 * 256 + (i) * 64) + voff); } while (0)
#define STOREK() do { _Pragma("unroll") for (int j = 0; j < 4; ++j) *(LAS u32x4*)(kst + j * 16 * 528) = st[j]; } while (0)
#define STOREV() do { _Pragma("unroll") for (int j = 0; j < 4; ++j) *(LAS u32x4*)(vst + j * 64 * 144) = st[j]; } while (0)
        f32x4 sc[16];
        LOADK(0);
#pragma unroll
        for (int i = 0; i < 4; ++i) {
            __syncthreads(); STOREK(); __syncthreads();
            if (i < 3) LOADK(i + 1); else LOADV(0);
            if (active) {
#pragma unroll
                for (int sub = 0; sub < 4; ++sub) {
                    f32x4 a = {0.f, 0.f, 0.f, 0.f};
#pragma unroll
                    for (int ks = 0; ks < 8; ++ks) {
                        const bf16x8 kf = *(const LAS bf16x8*)(krd + sub * 16 * 528 + ks * 64);
                        a = __builtin_amdgcn_mfma_f32_16x16x32_bf16(kf, qf[ks], a, 0, 0, 0);
                    }
                    sc[i * 4 + sub] = a;
                }
            }
        }
        float linv = 0.f;
        if (active) {
            float mx = -3.0e38f;
#pragma unroll
            for (int t = 0; t < 16; ++t)
#pragma unroll
                for (int j = 0; j < 4; ++j) mx = fmaxf(mx, sc[t][j]);
            mx = fmaxf(mx, __shfl_xor(mx, 16)); mx = fmaxf(mx, __shfl_xor(mx, 32));
            float l = 0.f;
#pragma unroll
            for (int t = 0; t < 16; ++t) {
                float e[4];
#pragma unroll
                for (int j = 0; j < 4; ++j) { e[j] = __expf(sc[t][j] - mx); l += e[j]; }
                u32x2 wv; wv.x = cvt_pk_bf16(e[0], e[1]); wv.y = cvt_pk_bf16(e[2], e[3]);
                *(LAS u32x2*)(pw + t * 32) = wv;
            }
            l += __shfl_xor(l, 16); l += __shfl_xor(l, 32); linv = 1.0f / l;
        }
        f32x4 oa[16];
#pragma unroll
        for (int dt = 0; dt < 16; ++dt) oa[dt] = (f32x4){0.f, 0.f, 0.f, 0.f};
#pragma unroll 1
        for (int i = 0; i < 4; ++i) {
            __syncthreads(); STOREV(); __syncthreads();
            if (i < 3) LOADV(i + 1);
            if (active) {
#pragma unroll
                for (int ks = 0; ks < 2; ++ks) {
                    const bf16x8 pf = *(const LAS bf16x8*)(pw + fq * 8 + i * 128 + ks * 64);
#pragma unroll
                    for (int dt = 0; dt < 16; ++dt) {
                        const bf16x8 vf = *(const LAS bf16x8*)(vrd + dt * 16 * 144 + ks * 64);
                        oa[dt] = __builtin_amdgcn_mfma_f32_16x16x32_bf16(vf, pf, oa[dt], 0, 0, 0);
                    }
                }
            }
        }
        if (active) {
            bf16_t* dst = ao + (size_t)(r0 + w * 16 + fr) * D + h * 256 + fq * 4;
#pragma unroll
            for (int dt = 0; dt < 16; ++dt) { u32x2 wv; wv.x = cvt_pk_bf16(oa[dt][0] * linv, oa[dt][1] * linv); wv.y = cvt_pk_bf16(oa[dt][2] * linv, oa[dt][3] * linv); *(u32x2*)(dst + dt * 16) = wv; }
        }
        __syncthreads();
#undef LOADK
#undef LOADV
#undef STOREK
#undef STOREV
    }
}

__device__ __forceinline__ void ph_final(const Params& p) {
    const int tid = opaque_tid(), lane = tid & 63, wid = tid >> 6; const int gw = blockIdx.x * 8 + wid, nw = gridDim.x * 8;
    f32x4 gn[4], cur[4], nxt[4];
#pragma unroll
    for (int i = 0; i < 4; ++i) gn[i] = ((const f32x4*)p.in[34])[i * 64 + lane];
    int row = gw;
    if (row < NTOK) { const f32x4* x = (const f32x4*)(p.out + (size_t)row * D);
#pragma unroll
        for (int i = 0; i < 4; ++i) cur[i] = x[i * 64 + lane]; }
#pragma unroll 1
    for (; row < NTOK; row += nw) {
        const int nr = row + nw;
        if (nr < NTOK) { const f32x4* x = (const f32x4*)(p.out + (size_t)nr * D);
#pragma unroll
            for (int i = 0; i < 4; ++i) nxt[i] = x[i * 64 + lane]; }
        float ss = 0.f;
#pragma unroll
        for (int i = 0; i < 4; ++i) ss += (cur[i][0] * cur[i][0] + cur[i][1] * cur[i][1]) + (cur[i][2] * cur[i][2] + cur[i][3] * cur[i][3]);
        ss = red64(ss); const float rs = rsqrtf(ss * (1.0f / 1024.0f) + 1e-6f);
        f32x4* xo = (f32x4*)(p.out + (size_t)row * D);
#pragma unroll
        for (int i = 0; i < 4; ++i) xo[i * 64 + lane] = cur[i] * rs * gn[i];
#pragma unroll
        for (int i = 0; i < 4; ++i) cur[i] = nxt[i];
    }
}

#define XB_TMO      128
#define XB_XCNT(j)  (256  + 64 * (j))
#define XB_XSUB(j)  (1280 + 64 * (j))
#define XB_XGEN(j)  (2304 + 64 * (j))
#define XB_TOP      3328
#define XB_TOPGEN   3392
#define XCD_BAR_WORDS 3456
#define XB_SPIN_CAP (1u << 18)

__device__ __forceinline__ unsigned xb_ld(unsigned* p)              { return __hip_atomic_load(p, __ATOMIC_RELAXED, __HIP_MEMORY_SCOPE_AGENT); }
__device__ __forceinline__ unsigned xb_add(unsigned* p, unsigned v) { return __hip_atomic_fetch_add(p, v, __ATOMIC_RELAXED, __HIP_MEMORY_SCOPE_AGENT); }
__device__ __forceinline__ unsigned xb_xcc_id() { return (unsigned)__builtin_amdgcn_s_getreg((3 << 11) | 20) & 0xFu; }
#define XB_SPIN(cond, bar) do { unsigned _sp = 0; while (cond) { __builtin_amdgcn_s_sleep(1); \
    if ((++_sp & 255u) == 0u) { if (xb_ld(&(bar)[XB_TMO])) break; if (_sp > XB_SPIN_CAP) { atomicAdd(&(bar)[XB_TMO], 1u); break; } } } } while (0)

struct XcdBarrier {
    unsigned* bar; unsigned x;
    volatile LAS unsigned* st;
};

__device__ __forceinline__ XcdBarrier xcd_barrier_post(unsigned* bar, volatile LAS unsigned* st) {
    XcdBarrier b; b.bar = bar; b.x = xb_xcc_id(); b.st = st;
    if (threadIdx.x == 0) (void)xb_add(&bar[XB_XCNT(b.x)], 1u);
    return b;
}
__device__ __forceinline__ void xcd_barrier_complete(unsigned* bar, unsigned x, unsigned& nloc, unsigned& nx) {
    const unsigned G = gridDim.x * gridDim.y * gridDim.z;
    unsigned sum, cnt, mine, sp = 0u;
    for (;;) {
        sum = 0u; cnt = 0u; mine = 0u;
#pragma unroll
        for (unsigned j = 0; j < 16; ++j) { const unsigned c = xb_ld(&bar[XB_XCNT(j)]); sum += c; cnt += (c > 0u) ? 1u : 0u; mine = (j == x) ? c : mine; }
        if (sum == G) break;
        __builtin_amdgcn_s_sleep(1);
        if ((++sp & 255u) == 0u) { if (xb_ld(&bar[XB_TMO])) break; if (sp > XB_SPIN_CAP) { atomicAdd(&bar[XB_TMO], 1u); break; } }
    }
    nloc = mine > 0u ? mine : 1u; nx = cnt > 0u ? cnt : 1u;
}

__device__ __forceinline__ void xcd_barrier(const XcdBarrier& b) {
    asm volatile("s_waitcnt vmcnt(0)" ::: "memory");
    __syncthreads();
    if (threadIdx.x == 0) {
        unsigned* bar = b.bar;
        __builtin_amdgcn_s_waitcnt(0);
        unsigned nloc = b.st[0], nx = b.st[1];
        if (nloc == 0u) { xcd_barrier_complete(bar, b.x, nloc, nx); b.st[0] = nloc; b.st[1] = nx; }
        const unsigned old = xb_add(&bar[XB_XSUB(b.x)], 1u);
        const unsigned gen = old / nloc;
        if (old + 1u == (gen + 1u) * nloc) {
            __builtin_amdgcn_fence(__ATOMIC_RELEASE, "agent");
            asm volatile("s_waitcnt vmcnt(0)" ::: "memory");
            const unsigned og = xb_add(&bar[XB_TOP], 1u);
            const unsigned tg = og / nx;
            if (og + 1u == (tg + 1u) * nx) xb_add(&bar[XB_TOPGEN], 1u);
            else XB_SPIN(xb_ld(&bar[XB_TOPGEN]) == tg, bar);
            __builtin_amdgcn_fence(__ATOMIC_ACQUIRE, "agent");
            xb_add(&bar[XB_XGEN(b.x)], 1u);
            asm volatile("s_waitcnt vmcnt(0)" ::: "memory");
        } else {
            XB_SPIN(xb_ld(&bar[XB_XGEN(b.x)]) == gen, bar);
            __builtin_amdgcn_fence(__ATOMIC_ACQUIRE, "agent");
            asm volatile("s_waitcnt vmcnt(0)" ::: "memory");
        }
    }
    __syncthreads();
}


__device__ __forceinline__ void grid_sync_cg() {
    asm volatile("s_waitcnt vmcnt(0) lgkmcnt(0)" ::: "memory");
    __syncthreads();
    if (threadIdx.x == 0) { __builtin_amdgcn_fence(__ATOMIC_RELEASE, "agent"); asm volatile("s_waitcnt vmcnt(0)" ::: "memory"); }
    cg::this_grid().sync();
    if (threadIdx.x < 64) { __builtin_amdgcn_fence(__ATOMIC_ACQUIRE, "agent"); asm volatile("s_waitcnt vmcnt(0)" ::: "memory"); }
    __syncthreads();
}
__device__ __forceinline__ void grid_sync_fast(unsigned* bar, unsigned& epoch) {
    asm volatile("s_waitcnt vmcnt(0) lgkmcnt(0)" ::: "memory");
    __syncthreads();
    epoch += 1;
    if (threadIdx.x == 0) {
        __builtin_amdgcn_fence(__ATOMIC_RELEASE, "agent");
        asm volatile("s_waitcnt vmcnt(0)" ::: "memory");
        __hip_atomic_fetch_add(bar, 1u, __ATOMIC_RELAXED, __HIP_MEMORY_SCOPE_AGENT);
        const unsigned target = epoch * gridDim.x;
        while (__hip_atomic_load(bar, __ATOMIC_RELAXED, __HIP_MEMORY_SCOPE_AGENT) < target) __builtin_amdgcn_s_sleep(2);
        __builtin_amdgcn_fence(__ATOMIC_ACQUIRE, "agent");
        asm volatile("s_waitcnt vmcnt(0)" ::: "memory");
    }
    __syncthreads();
}
__global__ void __launch_bounds__(512, 2) mk_fwd(Params p) {
    extern __shared__ __attribute__((aligned(16))) unsigned char smem[];
    LAS unsigned char* lds = (LAS unsigned char*)smem;
    unsigned char* ws = p.ws; const int G = gridDim.x, bid = blockIdx.x;
    volatile LAS unsigned* st_ = (volatile LAS unsigned*)(lds + 131072);
    if (threadIdx.x == 0) { st_[0] = 0u; st_[1] = 0u; }
    __syncthreads();
    const XcdBarrier xb_ = xcd_barrier_post((unsigned*)(ws + WS_BAR), st_);
#ifndef PHMASK
#define PHMASK 0x1fff
#endif
#define IN(k) (((PHMASK >> (k)) & 1) && p.lo <= (k) && (k) < p.hi)
#ifndef DUPMASK
#define DUPMASK 0
#endif
#define REPS(k) for (int rep_ = 0; rep_ < 1 + ((DUPMASK >> (k)) & 1); ++rep_)
#define RSYNC() do { if (rep_) xcd_barrier(xb_); } while (0)
#define SEAM(k) do { if (IN(k) && IN((k) + 1)) xcd_barrier(xb_); } while (0)
    if (p.lo > 1000) grid_sync_cg();
    if (IN(0)) REPS(0) { RSYNC(); ph_prep(p, lds); }
    SEAM(0);
    if (IN(1)) REPS(1) { RSYNC();
        { pg8::Gemm g{(const bf16_t*)(ws + WS_A), (const bf16_t*)(ws + WS_WIN), NTOK, 3840, 1024}; pg8::StaticOrder S; S.init(NTOK, 3840, G, bid);
          EpiWin E{(bf16_t*)(ws + WS_PHG), (bf16_t*)(ws + WS_PRW), (const float*)(ws + WS_RS0), p.out + O_PSH, p.out + O_SSH}; pg8::gemm_phase(lds, g, S, E); }
        { pg8::Gemm g{(const bf16_t*)(ws + WS_MEMB), (const bf16_t*)(ws + WS_WKV), 2048, 2048, 1024}; pg8::StaticOrder S; S.init(2048, 2048, G, (bid + G - 160 % G) % G);
          EpiMemKV E{p.out + O_PMK, p.out + O_PMV, (const float*)(ws + WS_RSM)}; pg8::gemm_phase(lds, g, S, E); }
    }
    SEAM(1);
    if (IN(2)) { ph_rwprep(p); ph_kvconv(p, lds); ph_hgprep(p, lds); }
    SEAM(2);
    if (IN(3)) {
        const bool split = (G == 256);
        pg8::Gemm g{(const bf16_t*)(ws + WS_B), (const bf16_t*)(ws + WS_WLORA), NTOK, 1536, 256}; pg8::StaticOrder S;
        EpiLora E{p.out, (bf16_t*)((unsigned char*)p.out + 68157440), (bf16_t*)((unsigned char*)p.out + 68157440 + HALF512), (bf16_t*)(ws + WS_PRW), (bf16_t*)(ws + WS_PRW + HALF512),
                  (const bf16_t*)(ws + WS_B + 17039360), (const float*)(ws + WS_KKN), p.in[13], p.in[15], p.in[18], p.in[19]};
        if (!split) { S.init(NTOK, 1536, G, bid); pg8::gemm_phase(lds, g, S, E); __syncthreads(); ph_hgseq(p, lds, 0, G); }
        else {
            if (bid < 128) { S.init(NTOK, 1536, 128, bid); S.window(0, 640); }
            else { ph_hgseq(p, lds, 128, 128); __syncthreads(); S.init(NTOK, 1536, 128, bid - 128); S.window(640, 780); }
            pg8::gemm_phase(lds, g, S, E);
        }
    }
    SEAM(3);
    if (IN(4)) REPS(4) { RSYNC(); ph_scan(p, lds); }
    SEAM(4);
    if (IN(5)) ph_rwpost(p);
    SEAM(5);
    if (IN(6)) {
        sgemm_sample<0>(lds, (const bf16_t*)(ws + WS_B), (const bf16_t*)(ws + WS_WOUT), 1024, p.in[2], p.out, (bf16_t*)(ws + WS_PRW), (float*)(ws + WS_SSQ1), nullptr);
        pg8::Gemm g{(const bf16_t*)(ws + WS_B), (const bf16_t*)(ws + WS_WOUT), NTOKP, 1024, 1024}; pg8::StaticOrder S; S.init(NTOKP, 1024, G, bid);
        EpiRes E{p.in[0], p.in[2], p.out, (bf16_t*)(ws + WS_PRW), (float*)(ws + WS_SSQ1)}; pg8::gemm_phase(lds, g, S, E);
    }
    SEAM(6);
    if (IN(7)) {
        sgemm_sample<1>(lds, (const bf16_t*)(ws + WS_PRW), (const bf16_t*)(ws + WS_WCQ), 1024, nullptr, nullptr, (bf16_t*)(ws + WS_A), nullptr, (const float*)(ws + WS_SSQ1));
        pg8::Gemm g{(const bf16_t*)(ws + WS_PRW), (const bf16_t*)(ws + WS_WCQ), NTOKP, 1024, 1024}; pg8::StaticOrder S; S.init(NTOKP, 1024, G, bid);
        EpiQ E{(bf16_t*)(ws + WS_A), (const float*)(ws + WS_SSQ1)}; pg8::gemm_phase(lds, g, S, E);
    }
    SEAM(7);
    if (IN(8)) REPS(8) { RSYNC(); ph_attn(p, lds); }
    SEAM(8);
    if (IN(9)) {
        sgemm_sample<0>(lds, (const bf16_t*)(ws + WS_B), (const bf16_t*)(ws + WS_WCO), 1024, p.out + (size_t)NTOKP * D, p.out, (bf16_t*)(ws + WS_A), (float*)(ws + WS_SSQ2), nullptr);
        pg8::Gemm g{(const bf16_t*)(ws + WS_B), (const bf16_t*)(ws + WS_WCO), NTOKP, 1024, 1024}; pg8::StaticOrder S; S.init(NTOKP, 1024, G, bid);
        EpiRes E{p.out, p.out + (size_t)NTOKP * D, p.out, (bf16_t*)(ws + WS_A), (float*)(ws + WS_SSQ2)}; pg8::gemm_phase(lds, g, S, E);
    }
    SEAM(9);
    if (IN(10)) REPS(10) { RSYNC();
        pg8::Gemm g{(const bf16_t*)(ws + WS_A), (const bf16_t*)(ws + WS_WFF13), NTOK, 5632, 1024}; pg8::StaticOrder S; S.init(NTOK, 5632, G, bid);
        EpiFF13 E{(bf16_t*)(ws + WS_PHG), (const float*)(ws + WS_SSQ2)}; pg8::gemm_phase(lds, g, S, E);
    }
    SEAM(10);
    if (IN(11)) {
        sgemm_sample<0>(lds, (const bf16_t*)(ws + WS_PHG), (const bf16_t*)(ws + WS_WFF2), 2816, p.out + (size_t)NTOKP * D, p.out, nullptr, nullptr, nullptr);
        pg8::Gemm g{(const bf16_t*)(ws + WS_PHG), (const bf16_t*)(ws + WS_WFF2), NTOKP, 1024, 2816}; pg8::StaticOrder S; S.init(NTOKP, 1024, G, bid);
        EpiRes E{p.out, p.out + (size_t)NTOKP * D, p.out, nullptr, nullptr}; pg8::gemm_phase(lds, g, S, E);
    }
    SEAM(11);
    if (IN(12)) ph_final(p);
#undef IN
#undef SEAM
}

extern "C" void kernel_launch(void* const* d_in, const int* in_sizes, int n_in, void* d_out, int out_size, void* d_ws, size_t ws_size, hipStream_t stream) {
    static int grid = 0;
    if (grid == 0) {
        if (n_in != 35 || ws_size < WS_END) { fprintf(stderr, "kernel_launch: unexpected n_in %d or ws %zu < %zu\n", n_in, ws_size, (size_t)WS_END); grid = -1; return; }
        if (hipFuncSetAttribute((const void*)mk_fwd, hipFuncAttributeMaxDynamicSharedMemorySize, LDS_BYTES) != hipSuccess) { fprintf(stderr, "kernel_launch: hipFuncSetAttribute failed\n"); grid = -1; return; }
        int dev = 0, cus = 0, per_cu = 0;
        hipGetDevice(&dev); hipDeviceGetAttribute(&cus, hipDeviceAttributeMultiprocessorCount, dev);
        hipOccupancyMaxActiveBlocksPerMultiprocessor(&per_cu, (const void*)mk_fwd, 512, LDS_BYTES);
        (void)hipGetLastError();
        if (per_cu < 1) per_cu = 1;
        grid = cus > 0 ? cus : 256;
    }
    if (grid < 0) return;
    if (hipMemsetAsync((char*)d_ws + WS_BAR, 0, 14080, stream) != hipSuccess) { fprintf(stderr, "kernel_launch: memset of the barrier word failed\n"); return; }
    Params p{};
    for (int i = 0; i < 35; ++i) p.in[i] = (const float*)d_in[i];
    p.out = (float*)d_out; p.ws = (unsigned char*)d_ws;
#if MK_MULTI
    for (int ph = 0; ph < NPHASE; ++ph) { p.lo = ph; p.hi = ph + 1; hipLaunchKernelGGL(mk_fwd, dim3(grid), dim3(512), LDS_BYTES, stream, p); }
#else
    p.lo = 0; p.hi = NPHASE;
    void* args[] = {&p};
    hipError_t e = hipLaunchCooperativeKernel((const void*)mk_fwd, dim3(grid), dim3(512), args, LDS_BYTES, stream);
    if (e != hipSuccess) fprintf(stderr, "cooperative launch failed: %s (grid %d)\n", hipGetErrorString(e), grid);
#endif
}
```

```cpp
#include <hip/hip_runtime.h>
#include <hip/hip_cooperative_groups.h>
#include <cstdio>
namespace cg = cooperative_groups;

#ifndef MK_MULTI
#define MK_MULTI 0
#endif

#define LAS __attribute__((address_space(3)))
typedef unsigned short bf16_t;
typedef short bf16x8 __attribute__((ext_vector_type(8)));
typedef float f32x4 __attribute__((ext_vector_type(4)));
typedef float f32x2 __attribute__((ext_vector_type(2)));
typedef unsigned u32x4 __attribute__((ext_vector_type(4)));
typedef unsigned u32x2 __attribute__((ext_vector_type(2)));

constexpr int D = 1024, NTOKP = 32768, NTOKS = 512, NTOK = 33280, HGC = 2048, RWC = 1792, DFF = 2816;
constexpr int NPHASE = 13;
constexpr int LDS_BYTES = 131072 + 16;

constexpr size_t O_Y = 0, O_PHG = 34078720, O_PRW = 34603008, O_PSH = 34865152, O_PMK = 34879488, O_PMV = 36976640,
                 O_SHG = 39073792, O_SRW = 40122368, O_SSH = 40646656;
constexpr size_t WS_WIN = 0;
constexpr size_t WS_WLORA = WS_WIN + 7864320;
constexpr size_t WS_WOUT = WS_WLORA + 786432;
constexpr size_t WS_WCQ = WS_WOUT + 2097152;
constexpr size_t WS_WKV = WS_WCQ + 2097152;
constexpr size_t WS_WCO = WS_WKV + 4194304;
constexpr size_t WS_WFF13 = WS_WCO + 2097152;
constexpr size_t WS_WFF2 = WS_WFF13 + 11534336;
constexpr size_t WS_PHG = WS_WFF2 + 5767168;
constexpr size_t WS_PRW = WS_PHG + 136314880;
constexpr size_t WS_A = WS_PRW + 119275520;
constexpr size_t WS_B = WS_A + 68157440;
constexpr size_t WS_MEMB = WS_B + 68157440;
constexpr size_t WS_KB = WS_MEMB + 4194304;
constexpr size_t WS_VT = WS_KB + 12582912;
constexpr size_t WS_RS0 = WS_VT + 12582912;
constexpr size_t WS_RSM = WS_RS0 + 133120;
constexpr size_t WS_KKN = WS_RSM + 8192;
constexpr size_t WS_SSQ1 = WS_KKN + 1064960;
constexpr size_t WS_SSQ2 = WS_SSQ1 + 2129920;
constexpr size_t WS_OI = WS_SSQ2 + 2129920;
constexpr size_t WS_DECB = WS_OI + 34078720;
constexpr size_t WS_BAR = WS_DECB + 1081344;
constexpr size_t WS_END = WS_BAR + 14080;
constexpr size_t HALF512 = 34078720;

struct Params {
    const float* in[35];
    float* out;
    unsigned char* ws;
    int lo, hi;
};

typedef __bf16 bf16x2_t __attribute__((ext_vector_type(2)));
__device__ __forceinline__ unsigned cvt_pk_bf16(float lo, float hi) { f32x2 f = {lo, hi}; bf16x2_t v = __builtin_convertvector(f, bf16x2_t); return __builtin_bit_cast(unsigned, v); }
__device__ __forceinline__ float bf_lo(unsigned w) { return __uint_as_float(w << 16); }
__device__ __forceinline__ float bf_hi(unsigned w) { return __uint_as_float(w & 0xffff0000u); }
__device__ __forceinline__ float bf1(bf16_t b) { return __uint_as_float(((unsigned)b) << 16); }
__device__ __forceinline__ bf16_t f2bf(float f) { return (bf16_t)(cvt_pk_bf16(f, 0.f) & 0xffffu); }
__device__ __forceinline__ float sigmoidf_(float x) { return __builtin_amdgcn_rcpf(1.0f + __expf(-x)); }
__device__ __forceinline__ void unpack8(const u32x4 w, float* f) {
    f[0] = bf_lo(w.x); f[1] = bf_hi(w.x); f[2] = bf_lo(w.y); f[3] = bf_hi(w.y); f[4] = bf_lo(w.z); f[5] = bf_hi(w.z); f[6] = bf_lo(w.w); f[7] = bf_hi(w.w);
}
__device__ __forceinline__ u32x4 pack8(const float* f) {
    u32x4 w; w.x = cvt_pk_bf16(f[0], f[1]); w.y = cvt_pk_bf16(f[2], f[3]); w.z = cvt_pk_bf16(f[4], f[5]); w.w = cvt_pk_bf16(f[6], f[7]); return w;
}
__device__ __forceinline__ int opaque_tid() { int t = threadIdx.x; asm volatile("" : "+v"(t)); return t; }
template <int CTRL> __device__ __forceinline__ float dppf(float x) {
    return __int_as_float(__builtin_amdgcn_update_dpp(0, __float_as_int(x), CTRL, 0xf, 0xf, true));
}
__device__ __forceinline__ float red4(float x) { x += dppf<0xB1>(x); x += dppf<0x4E>(x); return x; }
__device__ __forceinline__ float red8(float x) { x = red4(x); x += dppf<0x141>(x); return x; }
__device__ __forceinline__ float red16(float x) { x = red8(x); x += dppf<0x140>(x); return x; }
__device__ __forceinline__ float red64(float x) { x = red16(x); x += __shfl_xor(x, 16); x += __shfl_xor(x, 32); return x; }

namespace pg8 {
constexpr int BM = 256, BK = 64, HALF = 128, HTB = HALF * BK * 2, STAGE_BYTES = 8 * HTB, NXCD = 8, WGM = 8;
__device__ __forceinline__ int lds_byte(int r, int c) { const int st = (r >> 4) * 2 + (c >> 5), rr = r & 15, cc = c & 31, ob = rr * 64 + cc * 2; return st * 1024 + (ob ^ (((ob >> 9) & 1) << 5)); }
__device__ __forceinline__ void stage_rc(int b, int& R, int& C) { const int st = b / 1024, sb = b % 1024, swz = sb ^ (((sb >> 9) & 1) << 5); R = (st >> 1) * 16 + swz / 64; C = (st & 1) * 32 + (swz % 64) / 2; }
__device__ __forceinline__ int perm32(int rho) { const int n = rho >> 4, i = rho & 15; return 8 * (i >> 2) + 4 * n + (i & 3); }
struct Unit { int pm, pn; };
struct Gemm { const bf16_t* A; const bf16_t* Bt; int M, N, K; };
struct StaticOrder {
    int nM, nN, nwg, G, c, base, cap;
    __device__ __forceinline__ void init(int M, int N, int G_, int c_) { nM = M / BM; nN = N / BM; nwg = nM * nN; G = G_; c = c_; base = 0; cap = nwg; }
    __device__ __forceinline__ void window(int base_, int cap_) { base = base_; cap = cap_ < nwg ? cap_ : nwg; }
    __device__ bool next(int i, Unit& u) const {
        const long L = (long)base + (long)i * G + c; if (L >= cap) return false;
        int wgid = (int)L; { const int q = nwg / NXCD, r = nwg % NXCD, xcd = wgid % NXCD, off = wgid / NXCD; wgid = (xcd < r ? xcd * (q + 1) : r * (q + 1) + (xcd - r) * q) + off; }
        const int nig = WGM * nN, gid = wgid / nig, fm = gid * WGM, gsz = (nM - fm) < WGM ? (nM - fm) : WGM;
        u.pm = fm + ((wgid % nig) % gsz); u.pn = (wgid % nig) / gsz; return true;
    }
};
template <class Epi, bool ALIGN_EPI = true, bool SP2 = true>
__device__ __forceinline__ void gemm_phase(LAS unsigned char* lds, const Gemm g, const StaticOrder& S, const Epi& E) {
    const int tid = opaque_tid(), wid = __builtin_amdgcn_readfirstlane(tid >> 6), lane = tid & 63, wr = wid >> 2, wc = wid & 3, fr = lane & 15, fq = lane >> 4;
    const int K = g.K, nt = K / BK;
    unsigned voffA[2], voffB[2];
#pragma unroll
    for (int i = 0; i < 2; ++i) { int R, C; stage_rc(tid * 16 + i * 8192, R, C); const int Rb = Epi::PERM ? ((R & ~31) + perm32(R & 31)) : R;
        voffA[i] = (unsigned)(R * K + C) * 2u; voffB[i] = (unsigned)(Rb * K + C) * 2u; }
    const size_t kstep = (size_t)(BK * 2);
    const size_t hstep = (size_t)HALF * K * 2;
    const size_t tstep = 2 * hstep;
    const unsigned ldsw = (unsigned)wid * 1024u;
    const int aoff = lds_byte(wr * 64 + fr, fq * 8), boff = lds_byte(wc * 32 + fr, fq * 8);
#define PG8_SA(b, h) (((b) * 2 + (h)) * HTB)
#define PG8_SB(b, h) ((4 + (b) * 2 + (h)) * HTB)
#define PG8_STAGE(bufoff, gbase, voff) do { _Pragma("unroll") for (int _i = 0; _i < 2; ++_i) \
        __builtin_amdgcn_global_load_lds((const unsigned*)((const char*)(gbase) + (voff)[_i]), (LAS unsigned*)(lds + (bufoff) + ldsw + _i * 8192), 16, 0, 0); } while (0)
#define PG8_LDA(dst, b, h) do { _Pragma("unroll") for (int m = 0; m < 4; ++m) _Pragma("unroll") for (int k = 0; k < 2; ++k) dst[m][k] = *(const LAS bf16x8*)(lds + PG8_SA(b, h) + aoff + m * 2048 + k * 1024); } while (0)
#define PG8_LDB(dst, b, h) do { _Pragma("unroll") for (int n = 0; n < 2; ++n) _Pragma("unroll") for (int k = 0; k < 2; ++k) dst[n][k] = *(const LAS bf16x8*)(lds + PG8_SB(b, h) + boff + n * 2048 + k * 1024); } while (0)
#define PG8_MMA(ai, bj, At, Bt) do { __builtin_amdgcn_s_setprio(1); _Pragma("unroll") for (int m = 0; m < 4; ++m) _Pragma("unroll") for (int n = 0; n < 2; ++n) _Pragma("unroll") for (int k = 0; k < 2; ++k) \
        acc[ai][bj][m][n] = __builtin_amdgcn_mfma_f32_16x16x32_bf16(Bt[n][k], At[m][k], acc[ai][bj][m][n], 0, 0, 0); __builtin_amdgcn_s_setprio(0); } while (0)
#define PG8_WAIT_V(n) asm volatile("s_waitcnt vmcnt(" #n ")" ::: "memory")
#define PG8_WAIT_L(n) asm volatile("s_waitcnt lgkmcnt(" #n ")" ::: "memory")
#define PG8_BAR __builtin_amdgcn_s_barrier()
#define PG8_SCHED __builtin_amdgcn_sched_barrier(0)
    Unit cur, nxt; int ui = 0;
    if (!S.next(0, cur)) return;
    f32x4 acc[2][2][4][2];
#pragma unroll
    for (int a = 0; a < 2; ++a)
#pragma unroll
        for (int b = 0; b < 2; ++b)
#pragma unroll
            for (int m = 0; m < 4; ++m)
#pragma unroll
                for (int n = 0; n < 2; ++n) acc[a][b][m][n] = (f32x4){0.f, 0.f, 0.f, 0.f};
    bf16x8 At[4][2], B0[2][2], B1[2][2];
    const char* cA = (const char*)g.A + (size_t)cur.pm * tstep; const char* cB = (const char*)g.Bt + (size_t)cur.pn * tstep;
    if constexpr (SP2) {
        PG8_STAGE(PG8_SB(0, 0), cB, voffB); PG8_STAGE(PG8_SB(0, 1), cB + hstep, voffB); PG8_STAGE(PG8_SA(0, 0), cA, voffA); PG8_STAGE(PG8_SA(0, 1), cA + hstep, voffA);
        if (wr == 1) PG8_BAR;
        PG8_WAIT_V(2); PG8_BAR;
        PG8_STAGE(PG8_SB(1, 0), cB + kstep, voffB); PG8_STAGE(PG8_SA(1, 0), cA + kstep, voffA); PG8_STAGE(PG8_SB(1, 1), cB + hstep + kstep, voffB);
        PG8_WAIT_V(6); PG8_BAR;
    } else {
        PG8_STAGE(PG8_SB(0, 0), cB, voffB); PG8_STAGE(PG8_SA(0, 0), cA, voffA); PG8_STAGE(PG8_SB(0, 1), cB + hstep, voffB); PG8_STAGE(PG8_SA(0, 1), cA + hstep, voffA);
        if (wr == 1) PG8_BAR;
        PG8_WAIT_V(4); PG8_BAR;
        PG8_STAGE(PG8_SB(1, 0), cB + kstep, voffB); PG8_STAGE(PG8_SA(1, 0), cA + kstep, voffA); PG8_STAGE(PG8_SB(1, 1), cB + hstep + kstep, voffB);
        PG8_WAIT_V(6); PG8_BAR;
    }
    for (;;) {
        const bool has_next = S.next(ui + 1, nxt);
        const char* nA = has_next ? (const char*)g.A + (size_t)nxt.pm * tstep : cA; const char* nB = has_next ? (const char*)g.Bt + (size_t)nxt.pn * tstep : cB;
#pragma unroll 1
        for (int t = 0; t < nt; t += 2) {
            const bool last = (t == nt - 2);
            const char* a1 = cA + (size_t)(t + 1) * kstep;
            const char* a2 = last ? nA : cA + (size_t)(t + 2) * kstep; const char* b2 = last ? nB : cB + (size_t)(t + 2) * kstep;
            const char* a3 = a2 + kstep; const char* b3 = b2 + kstep;
            if constexpr (SP2) {
            PG8_LDB(B0, 0, 0); PG8_LDB(B1, 0, 1); PG8_SCHED; PG8_LDA(At, 0, 0); PG8_STAGE(PG8_SA(1, 1), a1 + hstep, voffA);
            PG8_WAIT_V(8); PG8_WAIT_L(0); PG8_BAR; PG8_MMA(0, 0, At, B0); PG8_MMA(0, 1, At, B1); PG8_BAR; PG8_SCHED;
            PG8_LDA(At, 0, 1); PG8_STAGE(PG8_SB(0, 0), b2, voffB); PG8_STAGE(PG8_SB(0, 1), b2 + hstep, voffB); PG8_STAGE(PG8_SA(0, 0), a2, voffA);
            PG8_WAIT_V(8); PG8_WAIT_L(0); PG8_BAR; PG8_MMA(1, 0, At, B0); PG8_MMA(1, 1, At, B1); PG8_BAR; PG8_SCHED;
            PG8_LDB(B0, 1, 0); PG8_LDB(B1, 1, 1); PG8_SCHED; PG8_LDA(At, 1, 0); PG8_STAGE(PG8_SA(0, 1), a2 + hstep, voffA);
            PG8_WAIT_V(8); PG8_WAIT_L(0); PG8_BAR; PG8_MMA(0, 0, At, B0); PG8_MMA(0, 1, At, B1); PG8_BAR; PG8_SCHED;
            PG8_LDA(At, 1, 1); PG8_STAGE(PG8_SB(1, 0), b3, voffB); PG8_STAGE(PG8_SB(1, 1), b3 + hstep, voffB); PG8_STAGE(PG8_SA(1, 0), a3, voffA);
            PG8_WAIT_V(8); PG8_WAIT_L(0); PG8_BAR; PG8_MMA(1, 0, At, B0); PG8_MMA(1, 1, At, B1); PG8_BAR; PG8_SCHED;
            } else {
            PG8_LDB(B0, 0, 0); PG8_SCHED; PG8_LDA(At, 0, 0); PG8_STAGE(PG8_SA(1, 1), a1 + hstep, voffA);
            PG8_WAIT_L(8); PG8_BAR; PG8_WAIT_L(0); PG8_MMA(0, 0, At, B0); PG8_BAR; PG8_SCHED;
            PG8_LDB(B1, 0, 1); PG8_STAGE(PG8_SB(0, 0), b2, voffB);
            PG8_BAR; PG8_WAIT_L(0); PG8_MMA(0, 1, At, B1); PG8_BAR;
            PG8_LDA(At, 0, 1); PG8_STAGE(PG8_SA(0, 0), a2, voffA);
            PG8_BAR; PG8_WAIT_L(0); PG8_MMA(1, 0, At, B0); PG8_BAR; PG8_SCHED;
            PG8_STAGE(PG8_SB(0, 1), b2 + hstep, voffB);
            PG8_WAIT_V(6); PG8_BAR; PG8_MMA(1, 1, At, B1); PG8_BAR;
            PG8_LDB(B0, 1, 0); PG8_SCHED; PG8_LDA(At, 1, 0); PG8_STAGE(PG8_SA(0, 1), a2 + hstep, voffA);
            PG8_WAIT_L(8); PG8_BAR; PG8_WAIT_L(0); PG8_MMA(0, 0, At, B0); PG8_BAR; PG8_SCHED;
            PG8_LDB(B1, 1, 1); PG8_STAGE(PG8_SB(1, 0), b3, voffB);
            PG8_BAR; PG8_WAIT_L(0); PG8_MMA(0, 1, At, B1); PG8_BAR;
            PG8_LDA(At, 1, 1); PG8_STAGE(PG8_SA(1, 0), a3, voffA);
            PG8_BAR; PG8_WAIT_L(0); PG8_MMA(1, 0, At, B0); PG8_BAR; PG8_SCHED;
            PG8_STAGE(PG8_SB(1, 1), b3 + hstep, voffB);
            PG8_WAIT_V(6); PG8_BAR; PG8_MMA(1, 1, At, B1); PG8_BAR;
            }
        }
        if constexpr (ALIGN_EPI) { if (wr == 0) PG8_BAR; }
        E(acc, cur, wr, wc, fr, fq);
        if (!has_next) break;
#pragma unroll
        for (int a = 0; a < 2; ++a)
#pragma unroll
            for (int b = 0; b < 2; ++b)
#pragma unroll
                for (int m = 0; m < 4; ++m)
#pragma unroll
                    for (int n = 0; n < 2; ++n) acc[a][b][m][n] = (f32x4){0.f, 0.f, 0.f, 0.f};
        cur = nxt; cA = nA; cB = nB; ++ui;
        if constexpr (ALIGN_EPI) { if (wr == 1) PG8_BAR; }
    }
    PG8_WAIT_V(0);
    if constexpr (!ALIGN_EPI) { if (wr == 0) PG8_BAR; }
    PG8_BAR;
#undef PG8_SA
#undef PG8_SB
#undef PG8_STAGE
#undef PG8_LDA
#undef PG8_LDB
#undef PG8_MMA
#undef PG8_WAIT_V
#undef PG8_WAIT_L
#undef PG8_BAR
#undef PG8_SCHED
}
}
using pg8::Unit;

__device__ __forceinline__ u32x4 pack_acc8(const f32x4 a, const f32x4 b, float s) {
    u32x4 w; w.x = cvt_pk_bf16(a[0] * s, a[1] * s); w.y = cvt_pk_bf16(a[2] * s, a[3] * s); w.z = cvt_pk_bf16(b[0] * s, b[1] * s); w.w = cvt_pk_bf16(b[2] * s, b[3] * s); return w;
}
__device__ __forceinline__ float rs_from_parts(const float* sp) {
    const f32x4 a = *(const f32x4*)sp, b = *(const f32x4*)(sp + 4), c = *(const f32x4*)(sp + 8), d = *(const f32x4*)(sp + 12);
    const float s = ((a[0] + a[1]) + (a[2] + a[3])) + ((b[0] + b[1]) + (b[2] + b[3])) + ((c[0] + c[1]) + (c[2] + c[3])) + ((d[0] + d[1]) + (d[2] + d[3]));
    return rsqrtf(s * (1.0f / 1024.0f) + 1e-6f);
}

__device__ __forceinline__ float rs_from_parts4(const float* sp, int fq) {
    const f32x4 a = *(const f32x4*)(sp + fq * 4); float s = (a[0] + a[1]) + (a[2] + a[3]);
    s += __shfl_xor(s, 16); s += __shfl_xor(s, 32);
    return rsqrtf(s * (1.0f / 1024.0f) + 1e-6f);
}
struct EpiWin {
    static constexpr bool PERM = true;
    bf16_t* phg; bf16_t* prw; const float* rs0; float* psh; float* ssh;
    __device__ __forceinline__ void operator()(const f32x4 (&acc)[2][2][4][2], const Unit& u, int wr, int wc, int fr, int fq) const {
        const int row0 = u.pm * 256 + wr * 64 + fr;
        const bool hg = u.pn < 8; bf16_t* base = hg ? phg : prw; const int ld = hg ? HGC : RWC; const int col0 = (hg ? u.pn : u.pn - 8) * 256 + wc * 32 + 8 * fq;
        float sv[8];
#pragma unroll
        for (int i = 0; i < 8; ++i) sv[i] = rs0[row0 + (i >> 2) * 128 + (i & 3) * 16];
#pragma unroll
        for (int ai = 0; ai < 2; ++ai)
#pragma unroll
            for (int m = 0; m < 4; ++m) {
                const int row = row0 + ai * 128 + m * 16; const float s = sv[ai * 4 + m]; bf16_t* rowp = base + (size_t)row * ld + col0;
#pragma unroll
                for (int bj = 0; bj < 2; ++bj) *(u32x4*)(rowp + bj * 128) = pack_acc8(acc[ai][bj][m][0], acc[ai][bj][m][1], s);
                if (!hg) {
                    bool last; float* dst;
                    if (row < NTOKP) { last = (row & 4095) == 4095; dst = psh + (row >> 12) * RWC; } else { const int rr = row - NTOKP; last = (rr & 31) == 31; dst = ssh + (rr >> 5) * RWC; }
                    if (last) {
#pragma unroll
                        for (int bj = 0; bj < 2; ++bj) { *(f32x4*)(dst + col0 + bj * 128) = acc[ai][bj][m][0] * s; *(f32x4*)(dst + col0 + bj * 128 + 4) = acc[ai][bj][m][1] * s; }
                    }
                }
            }
    }
};
struct EpiMemKV {
    static constexpr bool PERM = false;
    float* pmk; float* pmv; const float* rsm;
    __device__ __forceinline__ void operator()(const f32x4 (&acc)[2][2][4][2], const Unit& u, int wr, int wc, int fr, int fq) const {
        const int row0 = u.pm * 256 + wr * 64 + fr; const bool isk = u.pn < 4; float* base = isk ? pmk : pmv; const int col0 = (isk ? u.pn : u.pn - 4) * 256 + wc * 32 + 4 * fq;
        float sv[8];
#pragma unroll
        for (int i = 0; i < 8; ++i) sv[i] = rsm[row0 + (i >> 2) * 128 + (i & 3) * 16];
#pragma unroll
        for (int ai = 0; ai < 2; ++ai)
#pragma unroll
            for (int m = 0; m < 4; ++m) {
                const int row = row0 + ai * 128 + m * 16; const float s = sv[ai * 4 + m]; float* rowp = base + (size_t)row * D + col0;
#pragma unroll
                for (int bj = 0; bj < 2; ++bj)
#pragma unroll
                    for (int n = 0; n < 2; ++n) *(f32x4*)(rowp + bj * 128 + n * 16) = acc[ai][bj][m][n] * s;
            }
    }
};
struct EpiLora {
    static constexpr bool PERM = true;
    float* decay; bf16_t* kk; bf16_t* kka; bf16_t* kp; bf16_t* g; const bf16_t* xk; const float* kkn; const float* w0; const float* a0; const float* k_k; const float* k_a;
    __device__ __forceinline__ void operator()(const f32x4 (&acc)[2][2][4][2], const Unit& u, int wr, int wc, int fr, int fq) const {
        const int row0 = u.pm * 256 + wr * 64 + fr; const int type = u.pn >> 1; const int cb = (u.pn & 1) * 256 + wc * 32 + 8 * fq;
        if (type == 0) {
            float wv[2][8];
#pragma unroll
            for (int bj = 0; bj < 2; ++bj)
#pragma unroll
                for (int j = 0; j < 8; ++j) wv[bj][j] = w0[cb + bj * 128 + j];
#pragma unroll
            for (int ai = 0; ai < 2; ++ai)
#pragma unroll
                for (int m = 0; m < 4; ++m) {
                    const int row = row0 + ai * 128 + m * 16;
#pragma unroll
                    for (int bj = 0; bj < 2; ++bj) {
                        const size_t o = (size_t)row * 512 + cb + bj * 128; float d[8];
#pragma unroll
                        for (int j = 0; j < 8; ++j) { const float v = j < 4 ? acc[ai][bj][m][0][j] : acc[ai][bj][m][1][j - 4]; d[j] = __expf(-0.60653066f * sigmoidf_(wv[bj][j] + v)); }
                        *(f32x4*)(decay + o) = (f32x4){d[0], d[1], d[2], d[3]}; *(f32x4*)(decay + o + 4) = (f32x4){d[4], d[5], d[6], d[7]};
                    }
                }
        } else if (type == 1) {
#pragma unroll
            for (int ai = 0; ai < 2; ++ai)
#pragma unroll
                for (int mh = 0; mh < 2; ++mh) {
                    u32x4 xw[2][2]; float nr[2][2];
#pragma unroll
                    for (int m2 = 0; m2 < 2; ++m2) { const int row = row0 + ai * 128 + (mh * 2 + m2) * 16;
#pragma unroll
                        for (int bj = 0; bj < 2; ++bj) { xw[m2][bj] = *(const u32x4*)(xk + (size_t)row * 512 + cb + bj * 128); nr[m2][bj] = kkn[row * 8 + ((cb + bj * 128) >> 6)]; } }
#pragma unroll
                    for (int m2 = 0; m2 < 2; ++m2) { const int m = mh * 2 + m2; const int row = row0 + ai * 128 + m * 16;
#pragma unroll
                        for (int bj = 0; bj < 2; ++bj) {
                            const int c = cb + bj * 128; const size_t o = (size_t)row * 512 + c; float x[8], k1[8], k2[8], k3[8]; unpack8(xw[m2][bj], x);
#pragma unroll
                            for (int j = 0; j < 8; ++j) { const float v = j < 4 ? acc[ai][bj][m][0][j] : acc[ai][bj][m][1][j - 4]; const float a = sigmoidf_(a0[c + j] + v); const float kq = x[j] * k_k[c + j] * nr[m2][bj]; k1[j] = kq; k2[j] = kq * a; k3[j] = x[j] * (1.0f + (a - 1.0f) * k_a[c + j]); }
                            *(u32x4*)(kk + o) = pack8(k1); *(u32x4*)(kka + o) = pack8(k2); *(u32x4*)(kp + o) = pack8(k3);
                        } }
                }
        } else {
#pragma unroll
            for (int ai = 0; ai < 2; ++ai)
#pragma unroll
                for (int m = 0; m < 4; ++m) {
                    const int row = row0 + ai * 128 + m * 16;
#pragma unroll
                    for (int bj = 0; bj < 2; ++bj) *(u32x4*)(g + (size_t)row * 512 + cb + bj * 128) = pack_acc8(acc[ai][bj][m][0], acc[ai][bj][m][1], 1.0f);
                }
        }
    }
};
struct EpiRes {
    static constexpr bool PERM = false;
    const float* rp; const float* rs; float* out; bf16_t* xb; float* ssq;
    __device__ __forceinline__ void operator()(const f32x4 (&acc)[2][2][4][2], const Unit& u, int wr, int wc, int fr, int fq) const {
        const int row0 = u.pm * 256 + wr * 64 + fr; const int col0 = u.pn * 256 + wc * 32 + 4 * fq;
#pragma unroll
        for (int ai = 0; ai < 2; ++ai) {
            f32x4 rr[4][2][2];
#pragma unroll
            for (int m = 0; m < 4; ++m) {
                const int row = row0 + ai * 128 + m * 16;
                const float* rrow = (row < NTOKP ? rp + (size_t)row * D : rs + (size_t)(row - NTOKP) * D) + col0;
#pragma unroll
                for (int bj = 0; bj < 2; ++bj)
#pragma unroll
                    for (int n = 0; n < 2; ++n) rr[m][bj][n] = *(const f32x4*)(rrow + bj * 128 + n * 16);
            }
#pragma unroll
            for (int m = 0; m < 4; ++m) {
                const int row = row0 + ai * 128 + m * 16; float* orow = out + (size_t)row * D + col0; float ss = 0.f;
#pragma unroll
                for (int bj = 0; bj < 2; ++bj)
#pragma unroll
                    for (int n = 0; n < 2; ++n) {
                        const f32x4 x = rr[m][bj][n] + acc[ai][bj][m][n];
                        *(f32x4*)(orow + bj * 128 + n * 16) = x; ss += (x[0] * x[0] + x[1] * x[1]) + (x[2] * x[2] + x[3] * x[3]);
                        if (xb) { u32x2 w; w.x = cvt_pk_bf16(x[0], x[1]); w.y = cvt_pk_bf16(x[2], x[3]); *(u32x2*)(xb + (size_t)row * D + col0 + bj * 128 + n * 16) = w; }
                    }
                if (ssq) { ss += __shfl_xor(ss, 16); ss += __shfl_xor(ss, 32); if (fq == 0) ssq[row * 16 + u.pn * 4 + wc] = ss; }
            }
        }
    }
};
struct EpiQ {
    static constexpr bool PERM = true;
    bf16_t* q; const float* ssq;
    __device__ __forceinline__ void operator()(const f32x4 (&acc)[2][2][4][2], const Unit& u, int wr, int wc, int fr, int fq) const {
        const int row0 = u.pm * 256 + wr * 64 + fr; const int col0 = u.pn * 256 + wc * 32 + 8 * fq;
        float sv[8];
#pragma unroll
        for (int i = 0; i < 8; ++i) sv[i] = rs_from_parts4(ssq + (size_t)(row0 + (i >> 2) * 128 + (i & 3) * 16) * 16, fq) * 0.0625f;
#pragma unroll
        for (int ai = 0; ai < 2; ++ai)
#pragma unroll
            for (int m = 0; m < 4; ++m) {
                const int row = row0 + ai * 128 + m * 16; const float s = sv[ai * 4 + m]; bf16_t* rowp = q + (size_t)row * D + col0;
#pragma unroll
                for (int bj = 0; bj < 2; ++bj) *(u32x4*)(rowp + bj * 128) = pack_acc8(acc[ai][bj][m][0], acc[ai][bj][m][1], s);
            }
    }
};
struct EpiFF13 {
    static constexpr bool PERM = true;
    bf16_t* h; const float* ssq;
    __device__ __forceinline__ void operator()(const f32x4 (&acc)[2][2][4][2], const Unit& u, int wr, int wc, int fr, int fq) const {
        const int row0 = u.pm * 256 + wr * 64 + fr; const int col0 = u.pn * 128 + wc * 32 + 8 * fq;
        float sv[8];
#pragma unroll
        for (int i = 0; i < 8; ++i) sv[i] = rs_from_parts4(ssq + (size_t)(row0 + (i >> 2) * 128 + (i & 3) * 16) * 16, fq);
#pragma unroll
        for (int ai = 0; ai < 2; ++ai)
#pragma unroll
            for (int m = 0; m < 4; ++m) {
                const int row = row0 + ai * 128 + m * 16; const float s = sv[ai * 4 + m]; float o[8];
#pragma unroll
                for (int n = 0; n < 2; ++n)
#pragma unroll
                    for (int j = 0; j < 4; ++j) { const float a1 = acc[ai][0][m][n][j] * s, a3 = acc[ai][1][m][n][j] * s; o[n * 4 + j] = a1 * sigmoidf_(a1) * a3; }
                *(u32x4*)(h + (size_t)row * DFF + col0) = pack8(o);
            }
    }
};

template <int MODE>
__device__ __forceinline__ void sgemm_sample(LAS unsigned char* lds, const bf16_t* A, const bf16_t* Bt, int K, const float* resid, float* out, bf16_t* xb, float* ssq_out, const float* ssq_in) {
    const int tid = opaque_tid(), lane = tid & 63, w = __builtin_amdgcn_readfirstlane(tid >> 6), fr = lane & 15, fq = lane >> 4;
    const int u = blockIdx.x * 8 + w;
    const bool act = (gridDim.x == 256);
#pragma unroll 1
    for (int uu = u; uu < 2048; uu += gridDim.x * 8) {
        const int rt = uu >> 6, ct = uu & 63; const int row = NTOKP + rt * 16 + fr, col0 = ct * 16 + fq * 4;
        const bf16_t* ap = A + (size_t)row * K + fq * 8; const bf16_t* bp = Bt + (size_t)(ct * 16 + fr) * K + fq * 8;
        f32x4 acc = {0.f, 0.f, 0.f, 0.f};
#pragma unroll 8
        for (int ks = 0; ks < K / 32; ++ks) {
            const bf16x8 a = *(const bf16x8*)(ap + ks * 32); const bf16x8 b = *(const bf16x8*)(bp + ks * 32);
            acc = __builtin_amdgcn_mfma_f32_16x16x32_bf16(b, a, acc, 0, 0, 0);
        }
        if (MODE == 0) {
            const f32x4 x = *(const f32x4*)(resid + (size_t)(row - NTOKP) * D + col0) + acc;
            *(f32x4*)(out + (size_t)row * D + col0) = x;
            if (xb) { u32x2 wv; wv.x = cvt_pk_bf16(x[0], x[1]); wv.y = cvt_pk_bf16(x[2], x[3]); *(u32x2*)(xb + (size_t)row * D + col0) = wv; }
            if (ssq_out) {
                float ss = (x[0] * x[0] + x[1] * x[1]) + (x[2] * x[2] + x[3] * x[3]); ss += __shfl_xor(ss, 16); ss += __shfl_xor(ss, 32);
                if (fq == 0) *(LAS float*)(lds + (w * 16 + fr) * 4) = ss;
                __syncthreads();
                if (tid < 16) { float t = 0.f;
#pragma unroll
                    for (int i = 0; i < 8; ++i) t += *(const LAS float*)(lds + (i * 16 + tid) * 4);
                    const int g = (uu & 63) >> 3; float* sp = ssq_out + (size_t)(NTOKP + rt * 16 + tid) * 16; sp[g] = t; sp[8 + g] = 0.f; }
                __syncthreads();
            }
        } else {
            const float sc = rs_from_parts(ssq_in + (size_t)row * 16) * 0.0625f;
            u32x2 wv; wv.x = cvt_pk_bf16(acc[0] * sc, acc[1] * sc); wv.y = cvt_pk_bf16(acc[2] * sc, acc[3] * sc); *(u32x2*)(xb + (size_t)row * D + col0) = wv;
        }
    }
    (void)act;
    __syncthreads();
}

__device__ __forceinline__ void transpose_job(LAS float* tile, const float* src, int ldn, int K, int N, const float* gain, bf16_t* dst, int mode, int noff, int nbatch, size_t sstride, size_t dstride) {
    const int tid = opaque_tid(); const int tn = N / 64, tk = K / 64, per = tn * tk, total = per * nbatch;
    int t = blockIdx.x; if (t >= total) return;
    float v[8];
#define TR_LD(tt_) do { const int bb_ = (tt_) / per, t2_ = (tt_) % per; const int k0_ = (t2_ / tn) * 64, n0_ = (t2_ % tn) * 64; const float* s_ = src + (size_t)bb_ * sstride; \
        _Pragma("unroll") for (int i = 0; i < 8; ++i) { const int idx = tid + i * 512, kk = idx >> 6, nn = idx & 63; v[i] = s_[(size_t)(k0_ + kk) * ldn + n0_ + nn]; } \
        if (gain) { float g_[8]; _Pragma("unroll") for (int i = 0; i < 8; ++i) g_[i] = gain[k0_ + ((tid + i * 512) >> 6)]; _Pragma("unroll") for (int i = 0; i < 8; ++i) v[i] *= g_[i]; } } while (0)
    TR_LD(t);
#pragma unroll 1
    for (; t < total; t += gridDim.x) {
        const int bb = t / per, tt = t % per; const int k0 = (tt / tn) * 64, n0 = (tt % tn) * 64; bf16_t* d = dst + (size_t)bb * dstride;
#pragma unroll
        for (int i = 0; i < 8; ++i) { const int idx = tid + i * 512, kk = idx >> 6, nn = idx & 63; tile[kk * 65 + nn] = v[i]; }
        __syncthreads();
        if (t + (int)gridDim.x < total) TR_LD(t + (int)gridDim.x);
#pragma unroll
        for (int i = 0; i < 4; ++i) { const int idx = tid + i * 512, nn = idx >> 5, kp = idx & 31; const int n = n0 + nn;
            int r = n + noff; if (mode == 1) r = (n >> 7) * 256 + (n & 127); else if (mode == 2) r = (n >> 7) * 256 + 128 + (n & 127);
            *(unsigned*)(d + (size_t)r * K + k0 + 2 * kp) = cvt_pk_bf16(tile[(2 * kp) * 65 + nn], tile[(2 * kp + 1) * 65 + nn]); }
        __syncthreads();
    }
#undef TR_LD
}
__device__ __forceinline__ void transpose_wave(const float* src, int ldn, int K, int N, const float* gain, bf16_t* dst, int mode, int noff, int nbatch, size_t sstride, size_t dstride) {
    const int tid = opaque_tid(), lane = tid & 63, wid = tid >> 6; const int gw = blockIdx.x * 8 + wid, nw = gridDim.x * 8;
    const int tn = N / 64, tk = K / 64, per = tn * tk, total = per * nbatch;
#pragma unroll 1
    for (int t = gw; t < total; t += nw) {
        const int bb = t / per, tt = t - bb * per; const int k0 = (tt / tn) * 64, n0 = (tt % tn) * 64;
        const float* s_ = src + (size_t)bb * sstride + (size_t)k0 * ldn + n0 + lane; float v[64];
#pragma unroll
        for (int k = 0; k < 64; ++k) v[k] = s_[(size_t)k * ldn];
        if (gain) {
#pragma unroll
            for (int k = 0; k < 64; ++k) v[k] *= gain[k0 + k];
        }
        const int n = n0 + lane; int r = n + noff; if (mode == 1) r = (n >> 7) * 256 + (n & 127); else if (mode == 2) r = (n >> 7) * 256 + 128 + (n & 127);
        bf16_t* d = dst + (size_t)bb * dstride + (size_t)r * K + k0;
#pragma unroll
        for (int i = 0; i < 8; ++i) *(u32x4*)(d + i * 8) = pack8(v + i * 8);
    }
}
__device__ __forceinline__ void ph_prep(const Params& p, LAS unsigned char* lds) {
    const int tid = opaque_tid(), lane = tid & 63, wid = tid >> 6; const int gw = blockIdx.x * 8 + wid, nw = gridDim.x * 8;
    unsigned char* ws = p.ws;
    bf16_t* xb = (bf16_t*)(ws + WS_A); bf16_t* memb = (bf16_t*)(ws + WS_MEMB); float* rs0 = (float*)(ws + WS_RS0); float* rsm = (float*)(ws + WS_RSM);
    {
        const int TOT = NTOK + 2048; f32x4 cur[4], nxt[4];
#define RC_SRC(row) ((row) < NTOKP ? p.in[0] + (size_t)(row) * D : (row) < NTOK ? p.in[2] + (size_t)((row) - NTOKP) * D : p.in[1] + (size_t)((row) - NTOK) * D)
        int row = gw;
        if (row < TOT) { const f32x4* sp = (const f32x4*)RC_SRC(row);
#pragma unroll
            for (int i = 0; i < 4; ++i) cur[i] = sp[i * 64 + lane]; }
#pragma unroll 1
        for (; row < TOT; row += nw) {
            const int nr = row + nw;
            if (nr < TOT) { const f32x4* sp = (const f32x4*)RC_SRC(nr);
#pragma unroll
                for (int i = 0; i < 4; ++i) nxt[i] = sp[i * 64 + lane]; }
            float ss = 0.f;
#pragma unroll
            for (int i = 0; i < 4; ++i) ss += (cur[i][0] * cur[i][0] + cur[i][1] * cur[i][1]) + (cur[i][2] * cur[i][2] + cur[i][3] * cur[i][3]);
            ss = red64(ss);
            bf16_t* dstp = row < NTOK ? xb + (size_t)row * D : memb + (size_t)(row - NTOK) * D;
#pragma unroll
            for (int i = 0; i < 4; ++i) { u32x2 w2; w2.x = cvt_pk_bf16(cur[i][0], cur[i][1]); w2.y = cvt_pk_bf16(cur[i][2], cur[i][3]); ((u32x2*)dstp)[i * 64 + lane] = w2; }
            if (lane == 0) { if (row < NTOK) rs0[row] = rsqrtf(ss * (1.0f / 1024.0f) + 1e-6f); else rsm[row - NTOK] = rsqrtf(ss * (1.0f / 1024.0f) + 1e-6f); }
#pragma unroll
            for (int i = 0; i < 4; ++i) cur[i] = nxt[i];
        }
#undef RC_SRC
    }
    LAS float* tile = (LAS float*)lds;
#pragma unroll 1
    for (int job = 0; job < 9; ++job) {
        const float* src; const float* gain = nullptr; int ldn = 1024, K = 1024, N = 1024, mode = 0, noff = 0; size_t doff;
        switch (job) {
            case 0: src = p.in[10]; gain = p.in[9]; ldn = 3840; N = 3840; doff = WS_WIN; break;
            case 1: src = p.in[23]; doff = WS_WOUT; break;
            case 2: src = p.in[26]; gain = p.in[24]; doff = WS_WCQ; break;
            case 3: src = p.in[27]; gain = p.in[25]; doff = WS_WKV; break;
            case 4: src = p.in[28]; gain = p.in[25]; doff = WS_WKV; noff = 1024; break;
            case 5: src = p.in[29]; doff = WS_WCO; break;
            case 6: src = p.in[31]; gain = p.in[30]; ldn = 2816; N = 2816; mode = 1; doff = WS_WFF13; break;
            case 7: src = p.in[32]; gain = p.in[30]; ldn = 2816; N = 2816; mode = 2; doff = WS_WFF13; break;
            default: src = p.in[33]; K = 2816; doff = WS_WFF2; break;
        }
        transpose_job(tile, src, ldn, K, N, gain, (bf16_t*)(ws + doff), mode, noff, 1, 0, 0);
    }
    bf16_t* wl = (bf16_t*)(ws + WS_WLORA);
    for (int it = blockIdx.x * 512 + tid; it < 1536 * 32; it += gridDim.x * 512) {
        const int n = it % 1536, k0 = (it / 1536) * 8; const float* src = nullptr; int kb = 0, nn = n;
        if (n < 512) { if (k0 < 64) { src = p.in[14]; kb = k0; } }
        else if (n < 1024) { nn = n - 512; if (k0 >= 64 && k0 < 128) { src = p.in[16]; kb = k0 - 64; } }
        else { nn = n - 1024; if (k0 >= 128) { src = p.in[17]; kb = k0 - 128; } }
        float v[8];
#pragma unroll
        for (int j = 0; j < 8; ++j) v[j] = 0.f;
        if (src) {
#pragma unroll
            for (int j = 0; j < 8; ++j) v[j] = src[(kb + j) * 512 + nn];
        }
        *(u32x4*)(wl + (size_t)n * 256 + k0) = pack8(v);
    }
}

__device__ __forceinline__ void ph_rwprep(const Params& p) {
    const int tid = opaque_tid(), lane = tid & 63, wid = tid >> 6; const int gw = blockIdx.x * 8 + wid, nw = gridDim.x * 8;
    unsigned char* ws = p.ws;
    const bf16_t* prw = (const bf16_t*)(ws + WS_PRW);
    bf16_t* rb = (bf16_t*)(ws + WS_A); bf16_t* vb = (bf16_t*)(ws + WS_A + HALF512);
    bf16_t* al = (bf16_t*)(ws + WS_B); bf16_t* xk = (bf16_t*)(ws + WS_B + 17039360);
    float* kkn = (float*)(ws + WS_KKN);
    const float* mu = p.in[12]; const float* k_k = p.in[18];
    float mu8[3][8], mul[4], kk8[8];
#pragma unroll
    for (int i = 0; i < 3; ++i)
#pragma unroll
        for (int j = 0; j < 8; ++j) mu8[i][j] = mu[i * 512 + lane * 8 + j];
#pragma unroll
    for (int j = 0; j < 4; ++j) mul[j] = mu[1536 + lane * 4 + j];
#pragma unroll
    for (int j = 0; j < 8; ++j) kk8[j] = k_k[lane * 8 + j];
#pragma unroll 1
    for (int row = gw; row < NTOK; row += nw) {
        const float* sh = nullptr; bool first;
        if (row < NTOKP) first = (row & 4095) == 0; else { const int rr = row - NTOKP; first = (rr & 31) == 0; sh = p.in[7] + (size_t)(rr >> 5) * RWC; }
        const bf16_t* cur = prw + (size_t)row * RWC; const bf16_t* prv = first ? cur : cur - RWC;
        u32x4 cw[3], pw[3];
#pragma unroll
        for (int i = 0; i < 3; ++i) { cw[i] = *(const u32x4*)(cur + i * 512 + lane * 8); pw[i] = *(const u32x4*)(prv + i * 512 + lane * 8); }
        const u32x2 cl = *(const u32x2*)(cur + 1536 + lane * 4), pl = *(const u32x2*)(prv + 1536 + lane * 4);
        float pvf[3][8], plf[4];
#pragma unroll
        for (int i = 0; i < 3; ++i) unpack8(pw[i], pvf[i]);
        plf[0] = bf_lo(pl.x); plf[1] = bf_hi(pl.x); plf[2] = bf_lo(pl.y); plf[3] = bf_hi(pl.y);
        if (first) {
            if (sh) {
#pragma unroll
                for (int i = 0; i < 3; ++i) { const f32x4 a = *(const f32x4*)(sh + i * 512 + lane * 8), b2 = *(const f32x4*)(sh + i * 512 + lane * 8 + 4);
                    pvf[i][0] = a[0]; pvf[i][1] = a[1]; pvf[i][2] = a[2]; pvf[i][3] = a[3]; pvf[i][4] = b2[0]; pvf[i][5] = b2[1]; pvf[i][6] = b2[2]; pvf[i][7] = b2[3]; }
                const f32x4 a = *(const f32x4*)(sh + 1536 + lane * 4); plf[0] = a[0]; plf[1] = a[1]; plf[2] = a[2]; plf[3] = a[3];
            } else {
#pragma unroll
                for (int i = 0; i < 3; ++i)
#pragma unroll
                    for (int j = 0; j < 8; ++j) pvf[i][j] = 0.f;
                plf[0] = plf[1] = plf[2] = plf[3] = 0.f;
            }
        }
        const size_t o = (size_t)row * 512 + lane * 8;
#pragma unroll
        for (int i = 0; i < 3; ++i) {
            float c[8], x[8]; unpack8(cw[i], c);
#pragma unroll
            for (int j = 0; j < 8; ++j) x[j] = c[j] + (pvf[i][j] - c[j]) * mu8[i][j];
            if (i == 0) *(u32x4*)(rb + o) = pack8(x);
            else if (i == 2) *(u32x4*)(vb + o) = pack8(x);
            else {
                *(u32x4*)(xk + o) = pack8(x); float ss = 0.f;
#pragma unroll
                for (int j = 0; j < 8; ++j) { const float kv = x[j] * kk8[j]; ss += kv * kv; }
                ss = red8(ss);
                if ((lane & 7) == 0) kkn[row * 8 + (lane >> 3)] = 1.0f / fmaxf(sqrtf(ss), 1e-12f);
            }
        }
        {
            const float c[4] = {bf_lo(cl.x), bf_hi(cl.x), bf_lo(cl.y), bf_hi(cl.y)}; float x[4];
#pragma unroll
            for (int j = 0; j < 4; ++j) { float t = c[j] + (plf[j] - c[j]) * mul[j]; if (lane < 16) t = 1.0f - 2.0f * __builtin_amdgcn_rcpf(__expf(2.0f * t) + 1.0f); else if (lane >= 32) t = sigmoidf_(t); x[j] = t; }
            u32x2 w; w.x = cvt_pk_bf16(x[0], x[1]); w.y = cvt_pk_bf16(x[2], x[3]); *(u32x2*)(al + (size_t)row * 256 + lane * 4) = w;
        }
    }
}
__device__ __forceinline__ void ph_kvconv(const Params& p, LAS unsigned char* lds) {
    const int tid = opaque_tid(); unsigned char* ws = p.ws; bf16_t* kb = (bf16_t*)(ws + WS_KB); bf16_t* vt = (bf16_t*)(ws + WS_VT);
    const size_t per = 256 * 1024;
    {
        const size_t nvec = 24 * per / 4, stride = (size_t)gridDim.x * 512;
        for (size_t i0 = (size_t)blockIdx.x * 512 + tid; i0 < nvec; i0 += 4 * stride) {
            f32x4 v[4];
#pragma unroll
            for (int j = 0; j < 4; ++j) { const size_t i = i0 + j * stride; if (i < nvec) { const size_t e = i * 4; const int b = (int)(e / per); const size_t off = e % per;
                const float* src = b < 8 ? p.out + O_PMK + (size_t)b * per + off : p.in[3] + (size_t)(b - 8) * per + off; v[j] = *(const f32x4*)src; } }
#pragma unroll
            for (int j = 0; j < 4; ++j) { const size_t i = i0 + j * stride; if (i < nvec) { u32x2 w; w.x = cvt_pk_bf16(v[j][0], v[j][1]); w.y = cvt_pk_bf16(v[j][2], v[j][3]); *(u32x2*)(kb + i * 4) = w; } }
        }
    }
    LAS float* tile = (LAS float*)lds;
#pragma unroll 1
    for (int job = 0; job < 2; ++job) {
        const float* src = job ? p.in[4] : p.out + O_PMV; bf16_t* dst = job ? vt + 8 * per : vt; const int nb = job ? 16 : 8;
        transpose_job(tile, src, 1024, 256, 1024, nullptr, dst, 0, 0, nb, per, per);
    }
}

struct RwStep { f32x4 d, k, a, p, r; float v; };
__device__ __forceinline__ void rwkv_scan(const Params& p, LAS unsigned char* lds, int rowbase, int T, int h, int q4, const float* S0, float* Sout) {
    const int tid = opaque_tid(), lane = tid & 63, w = __builtin_amdgcn_readfirstlane(tid >> 6), rowl = lane >> 4, seg = lane & 15; const int vloc = (w & 3) * 4 + rowl, vrow = q4 * 16 + vloc;
    unsigned char* ws = p.ws;
    const float* decay = p.out; const bf16_t* kk = (const bf16_t*)((const unsigned char*)p.out + 68157440); const bf16_t* kka = (const bf16_t*)((const unsigned char*)p.out + 68157440 + HALF512);
    const bf16_t* kp = (const bf16_t*)(ws + WS_PRW); const bf16_t* rb = (const bf16_t*)(ws + WS_A); const bf16_t* vb = (const bf16_t*)(ws + WS_A + HALF512);
    bf16_t* ob = (bf16_t*)(ws + WS_B);
    const bool comp = w < 4;
    f32x4 S = (f32x4){0.f, 0.f, 0.f, 0.f};
    if (comp && S0) S = *(const f32x4*)(S0 + vrow * 64 + seg * 4);
    constexpr int BUF = 43008;
    const bool ldr = w >= 4; const int lt = tid & 255, lstep = lt >> 4, lj = lt & 15;
    f32x4 gd[2]; u32x2 gk[2], ga[2], gp[2], gr[2], gv[2];
    auto gload = [&](int c) {
        if (ldr) {
#pragma unroll
            for (int q = 0; q < 2; ++q) {
                const size_t row = (size_t)(rowbase + c * 32 + lstep + q * 16); const size_t o = row * 512 + h * 64 + lj * 4;
                gd[q] = *(const f32x4*)(decay + o); gk[q] = *(const u32x2*)(kk + o); ga[q] = *(const u32x2*)(kka + o); gp[q] = *(const u32x2*)(kp + o); gr[q] = *(const u32x2*)(rb + o);
                gv[q] = *(const u32x2*)(vb + row * 512 + h * 64 + q4 * 16 + (lj & 3) * 4);
            }
        }
    };
    auto up4 = [](const u32x2 x) { return (f32x4){bf_lo(x.x), bf_hi(x.x), bf_lo(x.y), bf_hi(x.y)}; };
    float selv[16];
#pragma unroll
    for (int i = 0; i < 16; ++i) selv[i] = (seg == i) ? 1.0f : 0.0f;
    const int nch = T / 32;
    gload(0);
#pragma unroll 1
    for (int c = 0; c < nch; ++c) {
        LAS unsigned char* b = lds + (c & 1) * BUF;
        if (ldr) {
#pragma unroll
            for (int q = 0; q < 2; ++q) {
                const int st_ = lstep + q * 16;
                *(LAS f32x4*)(b + st_ * 256 + lj * 16) = gd[q];
                *(LAS f32x4*)(b + 8192 + st_ * 256 + lj * 16) = up4(gk[q]);
                *(LAS f32x4*)(b + 16384 + st_ * 256 + lj * 16) = up4(ga[q]);
                *(LAS f32x4*)(b + 24576 + st_ * 256 + lj * 16) = up4(gp[q]);
                *(LAS f32x4*)(b + 32768 + st_ * 256 + lj * 16) = up4(gr[q]);
                if (lj < 4) *(LAS f32x4*)(b + 40960 + st_ * 64 + lj * 16) = up4(gv[q]);
            }
        }
        __syncthreads();
        if (c + 1 < nch) gload(c + 1);
        if (comp) {
            const LAS unsigned char* bs = b + seg * 16; const LAS unsigned char* bv = b + 40960 + vloc * 4;
#define RW_LD(X, s) do { X.d = *(const LAS f32x4*)(bs + (s) * 256); X.k = *(const LAS f32x4*)(bs + 8192 + (s) * 256); X.a = *(const LAS f32x4*)(bs + 16384 + (s) * 256); \
                         X.p = *(const LAS f32x4*)(bs + 24576 + (s) * 256); X.r = *(const LAS f32x4*)(bs + 32768 + (s) * 256); X.v = *(const LAS float*)(bv + (s) * 64); } while (0)
#define RW_STEP(X, s) do { float sa = fmaf(S[3], X.k[3], fmaf(S[2], X.k[2], fmaf(S[1], X.k[1], S[0] * X.k[0]))); const f32x4 T = S * X.d + X.v * X.p; sa = -red16(sa); \
                           S = T + sa * X.a; float y = fmaf(S[3], X.r[3], fmaf(S[2], X.r[2], fmaf(S[1], X.r[1], S[0] * X.r[0]))); y = red16(y); \
                           yk = fmaf(selv[(s) & 15], y, yk); } while (0)
            RwStep xa, xb, xc; float yk = 0.f;
#define RW_YST(s) do { if ((s) == 15) { ob[(size_t)(rowbase + c * 32 + seg) * D + 512 + h * 64 + vrow] = f2bf(yk); yk = 0.f; } } while (0)
            RW_LD(xa, 0); RW_LD(xb, 1);
#pragma unroll
            for (int s = 0; s < 30; s += 3) {
                RW_LD(xc, s + 2); RW_STEP(xa, s); RW_YST(s);
                RW_LD(xa, s + 3); RW_STEP(xb, s + 1); RW_YST(s + 1);
                RW_LD(xb, s + 4); RW_STEP(xc, s + 2); RW_YST(s + 2);
            }
            RW_STEP(xa, 30); RW_STEP(xb, 31);
            ob[(size_t)(rowbase + c * 32 + 16 + seg) * D + 512 + h * 64 + vrow] = f2bf(yk);
#undef RW_YST
#undef RW_LD
#undef RW_STEP
        }
    }
    if (comp) *(f32x4*)(Sout + vrow * 64 + seg * 4) = S;
    __syncthreads();
}

__device__ __forceinline__ void hg_prep_chunk(const Params& p, LAS unsigned char* lds, int task) {
    const int tid = opaque_tid(), lane = tid & 63, w = __builtin_amdgcn_readfirstlane(tid >> 6), fr = lane & 15, fq = lane >> 4;
    unsigned char* ws = p.ws; bf16_t* phg = (bf16_t*)(ws + WS_PHG); bf16_t* oi = (bf16_t*)(ws + WS_OI); float* decb = (float*)(ws + WS_DECB);
    constexpr int QG = 0, KG = 17408, VT = 34816, ATT = 53248, SEG = 62464;
    int row0, TC, h;
    if (task < 2048) { const int seq = task >> 6, ch = task & 63; h = seq & 3; row0 = (seq >> 2) * 4096 + ch * 64; TC = 64; }
    else { const int s = task - 2048; h = s & 3; row0 = NTOKP + (s >> 2) * 32; TC = 32; }
    const int c = tid & 127, sg = tid >> 7;
    const float l0 = p.in[8][h * 128 + c], l1 = p.in[8][512 + h * 128 + c]; const float lb = 1.0f / (1.0f + __expf(l1 - l0)), omlb = 1.0f - lb;
    const bool valid = sg * 16 < TC;
    float cp[16], kx[16], qv[16], vv[16]; float run = 1.f;
    {
        const bf16_t* rp = phg + (size_t)(row0 + (valid ? sg * 16 : 0)) * HGC + h * 128 + c; bf16_t rq[16], rf[16], rv[16];
#pragma unroll
        for (int j = 0; j < 16; ++j) { rq[j] = rp[(size_t)j * HGC]; rf[j] = rp[(size_t)j * HGC + 512]; rv[j] = rp[(size_t)j * HGC + 1024]; }
#pragma unroll
        for (int j = 0; j < 16; ++j) {
            const float sgm = sigmoidf_(bf1(rf[j])); const float f = valid ? lb + omlb * sgm : 1.0f; run *= f; cp[j] = run;
            kx[j] = valid ? omlb * (1.0f - sgm) : 0.f; qv[j] = valid ? bf1(rq[j]) : 0.f; vv[j] = valid ? bf1(rv[j]) : 0.f;
        }
    }
    *(LAS float*)(lds + SEG + (sg * 128 + c) * 4) = run;
    __syncthreads();
    float pre = 1.f, tot = 1.f;
#pragma unroll
    for (int s2 = 0; s2 < 4; ++s2) { const float x = *(const LAS float*)(lds + SEG + (s2 * 128 + c) * 4); tot *= x; if (s2 < sg) pre *= x; }
    {
        float kd[16];
#pragma unroll
        for (int j = 0; j < 16; ++j) {
            const float P = pre * cp[j]; const int t = sg * 16 + j; const float qg = qv[j] * P, kg = kx[j] * __builtin_amdgcn_rcpf(P);
            const bf16_t qgb = f2bf(qg);
            *(LAS bf16_t*)(lds + QG + t * 272 + c * 2) = qgb;
            *(LAS bf16_t*)(lds + KG + t * 272 + c * 2) = f2bf(kg);
            kd[j] = kg * tot;
            if (valid) phg[(size_t)(row0 + t) * HGC + h * 128 + c] = qgb;
        }
        const u32x4 v0 = pack8(vv), v1 = pack8(vv + 8);
        *(LAS u32x4*)(lds + VT + c * 144 + sg * 32) = v0; *(LAS u32x4*)(lds + VT + c * 144 + sg * 32 + 16) = v1;
        if (valid) {
            const int lin = c * TC + sg * 16; bf16_t* dst = phg + (size_t)(row0 + (lin >> 7)) * HGC + h * 128 + (lin & 127);
            *(u32x4*)(dst + 512) = pack8(kd); *(u32x4*)(dst + 512 + 8) = pack8(kd + 8);
            *(u32x4*)(dst + 1024) = v0; *(u32x4*)(dst + 1024 + 8) = v1;
        }
        if (sg == 0) decb[task * 128 + c] = tot;
    }
    __syncthreads();
    {
        const int tt = w >> 1;
#pragma unroll
        for (int q2 = 0; q2 < 2; ++q2) {
            const int st = 2 * (w & 1) + q2; f32x4 a = {0.f, 0.f, 0.f, 0.f};
#pragma unroll
            for (int ks = 0; ks < 4; ++ks) {
                const bf16x8 kf = *(const LAS bf16x8*)(lds + KG + (st * 16 + fr) * 272 + (ks * 32 + fq * 8) * 2);
                const bf16x8 qf = *(const LAS bf16x8*)(lds + QG + (tt * 16 + fr) * 272 + (ks * 32 + fq * 8) * 2);
                a = __builtin_amdgcn_mfma_f32_16x16x32_bf16(kf, qf, a, 0, 0, 0);
            }
            const int t = tt * 16 + fr; float m[4];
#pragma unroll
            for (int j = 0; j < 4; ++j) { const int s = st * 16 + fq * 4 + j; m[j] = (s <= t) ? a[j] : 0.f; }
            u32x2 wv; wv.x = cvt_pk_bf16(m[0], m[1]); wv.y = cvt_pk_bf16(m[2], m[3]);
            *(LAS u32x2*)(lds + ATT + t * 144 + (st * 16 + fq * 4) * 2) = wv;
        }
    }
    __syncthreads();
#pragma unroll
    for (int tt = 0; tt < 4; ++tt) {
        f32x4 a = {0.f, 0.f, 0.f, 0.f};
#pragma unroll
        for (int ks = 0; ks < 2; ++ks) {
            const bf16x8 vf = *(const LAS bf16x8*)(lds + VT + (w * 16 + fr) * 144 + (ks * 32 + fq * 8) * 2);
            const bf16x8 af = *(const LAS bf16x8*)(lds + ATT + (tt * 16 + fr) * 144 + (ks * 32 + fq * 8) * 2);
            a = __builtin_amdgcn_mfma_f32_16x16x32_bf16(vf, af, a, 0, 0, 0);
        }
        const int t = tt * 16 + fr;
        if (t < TC) { u32x2 wv; wv.x = cvt_pk_bf16(a[0], a[1]); wv.y = cvt_pk_bf16(a[2], a[3]); *(u32x2*)(oi + ((size_t)(h * 4 + (w >> 1)) * NTOK + row0 + t) * 32 + (w & 1) * 16 + fq * 4) = wv; }
    }
    __syncthreads();
}
__device__ __forceinline__ void ph_hgprep(const Params& p, LAS unsigned char* lds) {
#pragma unroll 1
    for (int t = blockIdx.x; t < 2112; t += gridDim.x) hg_prep_chunk(p, lds, t);
}
__device__ __forceinline__ void hg_seq(const Params& p, LAS unsigned char* lds, int task) {
    const int tid = opaque_tid(), lane = tid & 63, w = __builtin_amdgcn_readfirstlane(tid >> 6), fr = lane & 15, fq = lane >> 4;
    unsigned char* ws = p.ws; const bf16_t* phg = (const bf16_t*)(ws + WS_PHG); const bf16_t* oi = (const bf16_t*)(ws + WS_OI); const float* decb = (const float*)(ws + WS_DECB); bf16_t* ob = (bf16_t*)(ws + WS_B);
    constexpr int QG = 0, KDT = 17408, VT = 35840, ST = 40448;
    int rowbase, TC, h, vq, nch, dbase; const float* S0 = nullptr; float* Sout;
    if (task < 128) { const int b = task >> 4; h = (task >> 2) & 3; vq = task & 3; rowbase = b * 4096; TC = 64; nch = 64; dbase = (b * 4 + h) * 64; Sout = p.out + O_PHG + (size_t)(b * 4 + h) * 16384; }
    else { const int s = task - 128, b = s >> 4; h = (s >> 2) & 3; vq = s & 3; rowbase = NTOKP + b * 32; TC = 32; nch = 1; dbase = 2048 + b * 4 + h; S0 = p.in[5] + (size_t)(b * 4 + h) * 16384; Sout = p.out + O_SHG + (size_t)(b * 4 + h) * 16384; }
    f32x4 S[2];
#pragma unroll
    for (int vt = 0; vt < 2; ++vt)
#pragma unroll
        for (int j = 0; j < 4; ++j) S[vt][j] = S0 ? S0[(w * 16 + fq * 4 + j) * 128 + vq * 32 + vt * 16 + fr] : 0.f;
    const int tt = w >> 1, vt_o = w & 1;
    const int prow = tid >> 4, pcol = tid & 15;
    struct HgR { u32x4 gq[2], gk[2], gv; u32x2 go; f32x4 gdec; };
    auto gload = [&](HgR& R, int ch) {
        const int row0 = rowbase + ch * 64;
#pragma unroll
        for (int j = 0; j < 2; ++j) {
            const int r = prow + j * 32; const bool ok = r < TC;
            const bf16_t* src = phg + (size_t)(row0 + (ok ? r : 0)) * HGC + h * 128 + pcol * 8;
            R.gq[j] = *(const u32x4*)src; R.gk[j] = *(const u32x4*)(src + 512);
        }
        if (tid < 256) {
            const int r = tid >> 4; const bool ok = r < (TC >> 2);
            const bf16_t* src = phg + (size_t)(row0 + ((vq * 32 * TC) >> 7) + (ok ? r : 0)) * HGC + 1024 + h * 128 + pcol * 8;
            R.gv = *(const u32x4*)src;
        }
        { const int t = tt * 16 + fr; const bool ok = t < TC; R.go = *(const u32x2*)(oi + ((size_t)(h * 4 + vq) * NTOK + row0 + (ok ? t : 0)) * 32 + vt_o * 16 + fq * 4); }
        R.gdec = *(const f32x4*)(decb + (size_t)(dbase + ch) * 128 + w * 16 + fq * 4);
    };
    HgR ra, rb;
    gload(ra, 0); if (nch > 1) gload(rb, 1);
    auto body = [&](HgR& R, int ch) {
        const int row0 = rowbase + ch * 64;
#pragma unroll
        for (int j = 0; j < 2; ++j) {
            const int r = prow + j * 32; const u32x4 z4 = (u32x4){0u, 0u, 0u, 0u};
            *(LAS u32x4*)(lds + QG + r * 272 + pcol * 16) = (r < TC) ? R.gq[j] : z4;
            if (TC == 64) { const int lin = r * 128 + pcol * 8; *(LAS u32x4*)(lds + KDT + (lin >> 6) * 144 + (lin & 63) * 2) = R.gk[j]; }
            else if (r < 32) { const int lin = r * 128 + pcol * 8; *(LAS u32x4*)(lds + KDT + (lin >> 5) * 144 + (lin & 31) * 2) = R.gk[j]; }
        }
        if (TC == 32 && tid < 256) {
#pragma unroll
            for (int j = 0; j < 2; ++j) { const int i2 = tid + j * 256; *(LAS u32x4*)(lds + KDT + (i2 >> 2) * 144 + 64 + (i2 & 3) * 16) = (u32x4){0u, 0u, 0u, 0u}; }
        }
        if (tid < 256) {
            const int r = tid >> 4; const int lin = r * 128 + pcol * 8;
            if (TC == 64) *(LAS u32x4*)(lds + VT + (lin >> 6) * 144 + (lin & 63) * 2) = R.gv;
            else { if (r < 8) *(LAS u32x4*)(lds + VT + (lin >> 5) * 144 + (lin & 31) * 2) = R.gv;
                   *(LAS u32x4*)(lds + VT + (tid >> 3) * 144 + 64 + (tid & 3) * 16 + ((tid >> 2) & 1) * 0) = (u32x4){0u, 0u, 0u, 0u}; }
        }
#pragma unroll
        for (int vt = 0; vt < 2; ++vt) { u32x2 wv; wv.x = cvt_pk_bf16(S[vt][0], S[vt][1]); wv.y = cvt_pk_bf16(S[vt][2], S[vt][3]); *(LAS u32x2*)(lds + ST + (vt * 16 + fr) * 272 + (w * 16 + fq * 4) * 2) = wv; }
        const float oi0 = bf_lo(R.go.x), oi1 = bf_hi(R.go.x), oi2 = bf_lo(R.go.y), oi3 = bf_hi(R.go.y);
        S[0] = S[0] * R.gdec; S[1] = S[1] * R.gdec;
        __syncthreads();
        if (ch + 2 < nch) gload(R, ch + 2);
        {
            f32x4 a = {0.f, 0.f, 0.f, 0.f};
#pragma unroll
            for (int ks = 0; ks < 4; ++ks) {
                const bf16x8 sf = *(const LAS bf16x8*)(lds + ST + (vt_o * 16 + fr) * 272 + (ks * 32 + fq * 8) * 2);
                const bf16x8 qf = *(const LAS bf16x8*)(lds + QG + (tt * 16 + fr) * 272 + (ks * 32 + fq * 8) * 2);
                a = __builtin_amdgcn_mfma_f32_16x16x32_bf16(sf, qf, a, 0, 0, 0);
            }
            const int t = tt * 16 + fr;
            if (t < TC) {
                u32x2 wv; wv.x = cvt_pk_bf16(a[0] + oi0, a[1] + oi1); wv.y = cvt_pk_bf16(a[2] + oi2, a[3] + oi3);
                *(u32x2*)((bf16_t*)oi + ((size_t)(h * 4 + vq) * NTOK + row0 + t) * 32 + vt_o * 16 + fq * 4) = wv;
            }
        }
#pragma unroll
        for (int vt = 0; vt < 2; ++vt) {
#pragma unroll
            for (int ks = 0; ks < 2; ++ks) {
                const bf16x8 kf = *(const LAS bf16x8*)(lds + KDT + (w * 16 + fr) * 144 + (ks * 32 + fq * 8) * 2);
                const bf16x8 vf = *(const LAS bf16x8*)(lds + VT + (vt * 16 + fr) * 144 + (ks * 32 + fq * 8) * 2);
                S[vt] = __builtin_amdgcn_mfma_f32_16x16x32_bf16(kf, vf, S[vt], 0, 0, 0);
            }
        }
        __syncthreads();
    };
#pragma unroll 1
    for (int ch = 0; ch < nch; ch += 2) { body(ra, ch); if (ch + 1 < nch) body(rb, ch + 1); }
#pragma unroll
    for (int vt = 0; vt < 2; ++vt)
#pragma unroll
        for (int j = 0; j < 4; ++j) Sout[(w * 16 + fq * 4 + j) * 128 + vq * 32 + vt * 16 + fr] = S[vt][j];
}
__device__ __forceinline__ void ph_hgseq(const Params& p, LAS unsigned char* lds, int first, int nblk) {
#pragma unroll 1
    for (int t = (int)blockIdx.x - first; t < 384; t += nblk) hg_seq(p, lds, t);
}
__device__ __forceinline__ void ph_scan(const Params& p, LAS unsigned char* lds) {
#pragma unroll 1
    for (int task = blockIdx.x; task < 768; task += gridDim.x) {
        if (task < 256) { const int b = task >> 5, h = (task >> 2) & 7, q4 = task & 3; rwkv_scan(p, lds, b * 4096, 4096, h, q4, nullptr, p.out + O_PRW + (size_t)(b * 8 + h) * 4096); }
        else { const int t = task - 256, b = t >> 5, h = (t >> 2) & 7, q4 = t & 3; rwkv_scan(p, lds, NTOKP + b * 32, 32, h, q4, p.in[6] + (size_t)(b * 8 + h) * 4096, p.out + O_SRW + (size_t)(b * 8 + h) * 4096); }
    }
}

__device__ __forceinline__ void ph_rwpost(const Params& p) {
    const int tid = opaque_tid(), lane = tid & 63, wid = tid >> 6; const int gw = blockIdx.x * 8 + wid, nw = gridDim.x * 8;
    unsigned char* ws = p.ws; bf16_t* ob = (bf16_t*)(ws + WS_B); const bf16_t* phg = (const bf16_t*)(ws + WS_PHG); const bf16_t* oi = (const bf16_t*)(ws + WS_OI);
    const bf16_t* kp = (const bf16_t*)(ws + WS_PRW); const bf16_t* gb = (const bf16_t*)(ws + WS_PRW + HALF512); const bf16_t* rb = (const bf16_t*)(ws + WS_A); const bf16_t* vb = (const bf16_t*)(ws + WS_A + HALF512);
    const int c = lane * 8; float rk[8], gw8[8], gb8[8], hn[8];
#pragma unroll
    for (int j = 0; j < 8; ++j) { rk[j] = p.in[20][c + j]; gw8[j] = p.in[21][c + j]; gb8[j] = p.in[22][c + j]; hn[j] = p.in[11][c + j]; }
    u32x4 cur[7], nxt[7];
#define RP_LD(X, row) do { const size_t o_ = (size_t)(row) * 512 + c; X[0] = *(const u32x4*)(ob + (size_t)(row) * D + 512 + c); X[1] = *(const u32x4*)(rb + o_); X[2] = *(const u32x4*)(kp + o_); \
        X[3] = *(const u32x4*)(vb + o_); X[4] = *(const u32x4*)(gb + o_); X[5] = *(const u32x4*)(oi + ((size_t)(c >> 5) * NTOK + (row)) * 32 + (c & 31)); X[6] = *(const u32x4*)(phg + (size_t)(row) * HGC + 1536 + c); } while (0)
    int row = gw;
    if (row < NTOK) RP_LD(cur, row);
#pragma unroll 1
    for (; row < NTOK; row += nw) {
        const int nr = row + nw;
        if (nr < NTOK) RP_LD(nxt, nr);
        float y[8], r[8], k[8], v[8], g[8], ho[8], hg[8];
        unpack8(cur[0], y); unpack8(cur[1], r); unpack8(cur[2], k); unpack8(cur[3], v); unpack8(cur[4], g); unpack8(cur[5], ho); unpack8(cur[6], hg);
        float s = 0.f, bs = 0.f, hs = 0.f;
#pragma unroll
        for (int j = 0; j < 8; ++j) { s += y[j]; bs += r[j] * k[j] * rk[j]; hs += ho[j] * ho[j]; }
        s = red8(s); bs = red8(bs); hs = red16(hs); const float mean = s * (1.0f / 64.0f); float q = 0.f;
#pragma unroll
        for (int j = 0; j < 8; ++j) { const float d = y[j] - mean; q += d * d; }
        q = red8(q); const float rstd = rsqrtf(q * (1.0f / 64.0f) + 64e-5f); const float hrs = rsqrtf(hs * (1.0f / 128.0f) + 1e-6f); float out[8], hout[8];
#pragma unroll
        for (int j = 0; j < 8; ++j) { out[j] = ((y[j] - mean) * rstd * gw8[j] + gb8[j] + bs * v[j]) * g[j]; hout[j] = ho[j] * hrs * hn[j] * (hg[j] * sigmoidf_(hg[j])); }
        *(u32x4*)(ob + (size_t)row * D + 512 + c) = pack8(out);
        *(u32x4*)(ob + (size_t)row * D + c) = pack8(hout);
#pragma unroll
        for (int i = 0; i < 7; ++i) cur[i] = nxt[i];
    }
#undef RP_LD
}

__device__ __forceinline__ void ph_attn(const Params& p, LAS unsigned char* lds) {
    const int tid = opaque_tid(), lane = tid & 63, w = __builtin_amdgcn_readfirstlane(tid >> 6), fr = lane & 15, fq = lane >> 4;
    unsigned char* ws = p.ws; const bf16_t* qb = (const bf16_t*)(ws + WS_A); const bf16_t* kb = (const bf16_t*)(ws + WS_KB); const bf16_t* vt = (const bf16_t*)(ws + WS_VT); bf16_t* ao = (bf16_t*)(ws + WS_B);
    constexpr int PR = 36864;
    LAS unsigned char* pw = lds + PR + w * 8448 + fr * 528 + fq * 8;
    const unsigned koff = (unsigned)((tid >> 5) * 1024 + (tid & 31) * 8);
    const unsigned voff = (unsigned)((tid >> 3) * 256 + (tid & 7) * 8);
    LAS unsigned char* kst = lds + (tid >> 5) * 528 + (tid & 31) * 16;
    LAS unsigned char* vst = lds + (tid >> 3) * 144 + (tid & 7) * 16;
    const LAS unsigned char* krd = lds + fr * 528 + fq * 16;
    const LAS unsigned char* vrd = lds + fr * 144 + fq * 16;
#pragma unroll 1
    for (int u = blockIdx.x; u < 1088; u += gridDim.x) {
        int r0, nrows, kvb, h;
        if (u < 1024) { const int tile = u >> 2; h = u & 3; r0 = tile * 128; nrows = 128; kvb = tile >> 5; }
        else { const int s = u - 1024, b = s >> 2; h = s & 3; r0 = NTOKP + b * 32; nrows = 32; kvb = 8 + b; }
        const bool active = (w * 16) < nrows;
        bf16x8 qf[8];
        if (active) {
            const bf16_t* qp = qb + (size_t)(r0 + w * 16 + fr) * D + h * 256 + fq * 8;
#pragma unroll
            for (int ks = 0; ks < 8; ++ks) qf[ks] = *(const bf16x8*)(qp + ks * 32);
        }
        u32x4 st[4];
        const bf16_t* kbase = kb + (size_t)kvb * 256 * 1024 + h * 256; const bf16_t* vbase = vt + ((size_t)kvb * 1024 + h * 256) * 256;
#define LOADK(i) do { _Pragma("unroll") for (int j = 0; j < 4; ++j) st[j] = *(const u32x4*)(kbase + ((i) * 64 + j * 16) * 1024 + koff); } while (0)
#define LOADV(i) do { _Pragma("unroll") for (int j = 0; j < 4; ++j) st[j] = *(const u32x4*)(vbase + (j * 64 * 256 + (i) * 64) + voff); } while (0)
#define STOREK() do { _Pragma("unroll") for (int j = 0; j < 4; ++j) *(LAS u32x4*)(kst + j * 16 * 528) = st[j]; } while (0)
#define STOREV() do { _Pragma("unroll") for (int j = 0; j < 4; ++j) *(LAS u32x4*)(vst + j * 64 * 144) = st[j]; } while (0)
        f32x4 sc[16];
        LOADK(0);
#pragma unroll
        for (int i = 0; i < 4; ++i) {
            __syncthreads(); STOREK(); __syncthreads();
            if (i < 3) LOADK(i + 1); else LOADV(0);
            if (active) {
#pragma unroll
                for (int sub = 0; sub < 4; ++sub) {
                    f32x4 a = {0.f, 0.f, 0.f, 0.f};
#pragma unroll
                    for (int ks = 0; ks < 8; ++ks) {
                        const bf16x8 kf = *(const LAS bf16x8*)(krd + sub * 16 * 528 + ks * 64);
                        a = __builtin_amdgcn_mfma_f32_16x16x32_bf16(kf, qf[ks], a, 0, 0, 0);
                    }
                    sc[i * 4 + sub] = a;
                }
            }
        }
        float linv = 0.f;
        if (active) {
            float mx = -3.0e38f;
#pragma unroll
            for (int t = 0; t < 16; ++t)
#pragma unroll
                for (int j = 0; j < 4; ++j) mx = fmaxf(mx, sc[t][j]);
            mx = fmaxf(mx, __shfl_xor(mx, 16)); mx = fmaxf(mx, __shfl_xor(mx, 32));
            float l = 0.f;
#pragma unroll
            for (int t = 0; t < 16; ++t) {
                float e[4];
#pragma unroll
                for (int j = 0; j < 4; ++j) { e[j] = __expf(sc[t][j] - mx); l += e[j]; }
                u32x2 wv; wv.x = cvt_pk_bf16(e[0], e[1]); wv.y = cvt_pk_bf16(e[2], e[3]);
                *(LAS u32x2*)(pw + t * 32) = wv;
            }
            l += __shfl_xor(l, 16); l += __shfl_xor(l, 32); linv = 1.0f / l;
        }
        f32x4 oa[16];
#pragma unroll
        for (int dt = 0; dt < 16; ++dt) oa[dt] = (f32x4){0.f, 0.f, 0.f, 0.f};
#pragma unroll 1
        for (int i = 0; i < 4; ++i) {
            __syncthreads(); STOREV(); __syncthreads();
            if (i < 3) LOADV(i + 1);
            if (active) {
#pragma unroll
                for (int ks = 0; ks < 2; ++ks) {
                    const bf16x8 pf = *(const LAS bf16x8*)(pw + fq * 8 + i * 128 + ks * 64);
#pragma unroll
                    for (int dt = 0; dt < 16; ++dt) {
                        const bf16x8 vf = *(const LAS bf16x8*)(vrd + dt * 16 * 144 + ks * 64);
                        oa[dt] = __builtin_amdgcn_mfma_f32_16x16x32_bf16(vf, pf, oa[dt], 0, 0, 0);
                    }
                }
            }
        }
        if (active) {
            bf16_t* dst = ao + (size_t)(r0 + w * 16 + fr) * D + h * 256 + fq * 4;
#pragma unroll
            for (int dt = 0; dt < 16; ++dt) { u32x2 wv; wv.x = cvt_pk_bf16(oa[dt][0] * linv, oa[dt][1] * linv); wv.y = cvt_pk_bf16(oa[dt][2] * linv, oa[dt][3] * linv); *(u32x2*)(dst + dt * 16) = wv; }
        }
        __syncthreads();
#undef LOADK
#undef LOADV
#undef STOREK
#undef STOREV
    }
}

__device__ __forceinline__ void ph_final(const Params& p) {
    const int tid = opaque_tid(), lane = tid & 63, wid = tid >> 6; const int gw = blockIdx.x * 8 + wid, nw = gridDim.x * 8;
    f32x4 gn[4], cur[4], nxt[4];
#pragma unroll
    for (int i = 0; i < 4; ++i) gn[i] = ((const f32x4*)p.in[34])[i * 64 + lane];
    int row = gw;
    if (row < NTOK) { const f32x4* x = (const f32x4*)(p.out + (size_t)row * D);
#pragma unroll
        for (int i = 0; i < 4; ++i) cur[i] = x[i * 64 + lane]; }
#pragma unroll 1
    for (; row < NTOK; row += nw) {
        const int nr = row + nw;
        if (nr < NTOK) { const f32x4* x = (const f32x4*)(p.out + (size_t)nr * D);
#pragma unroll
            for (int i = 0; i < 4; ++i) nxt[i] = x[i * 64 + lane]; }
        float ss = 0.f;
#pragma unroll
        for (int i = 0; i < 4; ++i) ss += (cur[i][0] * cur[i][0] + cur[i][1] * cur[i][1]) + (cur[i][2] * cur[i][2] + cur[i][3] * cur[i][3]);
        ss = red64(ss); const float rs = rsqrtf(ss * (1.0f / 1024.0f) + 1e-6f);
        f32x4* xo = (f32x4*)(p.out + (size_t)row * D);
#pragma unroll
        for (int i = 0; i < 4; ++i) xo[i * 64 + lane] = cur[i] * rs * gn[i];
#pragma unroll
        for (int i = 0; i < 4; ++i) cur[i] = nxt[i];
    }
}

#define XB_TMO      128
#define XB_XCNT(j)  (256  + 64 * (j))
#define XB_XSUB(j)  (1280 + 64 * (j))
#define XB_XGEN(j)  (2304 + 64 * (j))
#define XB_TOP      3328
#define XB_TOPGEN   3392
#define XCD_BAR_WORDS 3456
#define XB_SPIN_CAP (1u << 18)

__device__ __forceinline__ unsigned xb_ld(unsigned* p)              { return __hip_atomic_load(p, __ATOMIC_RELAXED, __HIP_MEMORY_SCOPE_AGENT); }
__device__ __forceinline__ unsigned xb_add(unsigned* p, unsigned v) { return __hip_atomic_fetch_add(p, v, __ATOMIC_RELAXED, __HIP_MEMORY_SCOPE_AGENT); }
__device__ __forceinline__ unsigned xb_xcc_id() { return (unsigned)__builtin_amdgcn_s_getreg((3 << 11) | 20) & 0xFu; }
#define XB_SPIN(cond, bar) do { unsigned _sp = 0; while (cond) { __builtin_amdgcn_s_sleep(1); \
    if ((++_sp & 255u) == 0u) { if (xb_ld(&(bar)[XB_TMO])) break; if (_sp > XB_SPIN_CAP) { atomicAdd(&(bar)[XB_TMO], 1u); break; } } } } while (0)

struct XcdBarrier {
    unsigned* bar; unsigned x;
    volatile LAS unsigned* st;
};

__device__ __forceinline__ XcdBarrier xcd_barrier_post(unsigned* bar, volatile LAS unsigned* st) {
    XcdBarrier b; b.bar = bar; b.x = xb_xcc_id(); b.st = st;
    if (threadIdx.x == 0) (void)xb_add(&bar[XB_XCNT(b.x)], 1u);
    return b;
}
__device__ __forceinline__ void xcd_barrier_complete(unsigned* bar, unsigned x, unsigned& nloc, unsigned& nx) {
    const unsigned G = gridDim.x * gridDim.y * gridDim.z;
    unsigned sum, cnt, mine, sp = 0u;
    for (;;) {
        sum = 0u; cnt = 0u; mine = 0u;
#pragma unroll
        for (unsigned j = 0; j < 16; ++j) { const unsigned c = xb_ld(&bar[XB_XCNT(j)]); sum += c; cnt += (c > 0u) ? 1u : 0u; mine = (j == x) ? c : mine; }
        if (sum == G) break;
        __builtin_amdgcn_s_sleep(1);
        if ((++sp & 255u) == 0u) { if (xb_ld(&bar[XB_TMO])) break; if (sp > XB_SPIN_CAP) { atomicAdd(&bar[XB_TMO], 1u); break; } }
    }
    nloc = mine > 0u ? mine : 1u; nx = cnt > 0u ? cnt : 1u;
}

__device__ __forceinline__ void xcd_barrier(const XcdBarrier& b) {
    asm volatile("s_waitcnt vmcnt(0)" ::: "memory");
    __syncthreads();
    if (threadIdx.x == 0) {
        unsigned* bar = b.bar;
        __builtin_amdgcn_s_waitcnt(0);
        unsigned nloc = b.st[0], nx = b.st[1];
        if (nloc == 0u) { xcd_barrier_complete(bar, b.x, nloc, nx); b.st[0] = nloc; b.st[1] = nx; }
        const unsigned old = xb_add(&bar[XB_XSUB(b.x)], 1u);
        const unsigned gen = old / nloc;
        if (old + 1u == (gen + 1u) * nloc) {
            __builtin_amdgcn_fence(__ATOMIC_RELEASE, "agent");
            asm volatile("s_waitcnt vmcnt(0)" ::: "memory");
            const unsigned og = xb_add(&bar[XB_TOP], 1u);
            const unsigned tg = og / nx;
            if (og + 1u == (tg + 1u) * nx) xb_add(&bar[XB_TOPGEN], 1u);
            else XB_SPIN(xb_ld(&bar[XB_TOPGEN]) == tg, bar);
            __builtin_amdgcn_fence(__ATOMIC_ACQUIRE, "agent");
            xb_add(&bar[XB_XGEN(b.x)], 1u);
            asm volatile("s_waitcnt vmcnt(0)" ::: "memory");
        } else {
            XB_SPIN(xb_ld(&bar[XB_XGEN(b.x)]) == gen, bar);
            __builtin_amdgcn_fence(__ATOMIC_ACQUIRE, "agent");
            asm volatile("s_waitcnt vmcnt(0)" ::: "memory");
        }
    }
    __syncthreads();
}


__device__ __forceinline__ void grid_sync_cg() {
    asm volatile("s_waitcnt vmcnt(0) lgkmcnt(0)" ::: "memory");
    __syncthreads();
    if (threadIdx.x == 0) { __builtin_amdgcn_fence(__ATOMIC_RELEASE, "agent"); asm volatile("s_waitcnt vmcnt(0)" ::: "memory"); }
    cg::this_grid().sync();
    if (threadIdx.x < 64) { __builtin_amdgcn_fence(__ATOMIC_ACQUIRE, "agent"); asm volatile("s_waitcnt vmcnt(0)" ::: "memory"); }
    __syncthreads();
}
__device__ __forceinline__ void grid_sync_fast(unsigned* bar, unsigned& epoch) {
    asm volatile("s_waitcnt vmcnt(0) lgkmcnt(0)" ::: "memory");
    __syncthreads();
    epoch += 1;
    if (threadIdx.x == 0) {
        __builtin_amdgcn_fence(__ATOMIC_RELEASE, "agent");
        asm volatile("s_waitcnt vmcnt(0)" ::: "memory");
        __hip_atomic_fetch_add(bar, 1u, __ATOMIC_RELAXED, __HIP_MEMORY_SCOPE_AGENT);
        const unsigned target = epoch * gridDim.x;
        while (__hip_atomic_load(bar, __ATOMIC_RELAXED, __HIP_MEMORY_SCOPE_AGENT) < target) __builtin_amdgcn_s_sleep(2);
        __builtin_amdgcn_fence(__ATOMIC_ACQUIRE, "agent");
        asm volatile("s_waitcnt vmcnt(0)" ::: "memory");
    }
    __syncthreads();
}
__global__ void __launch_bounds__(512, 2) mk_fwd(Params p) {
    extern __shared__ __attribute__((aligned(16))) unsigned char smem[];
    LAS unsigned char* lds = (LAS unsigned char*)smem;
    unsigned char* ws = p.ws; const int G = gridDim.x, bid = blockIdx.x;
    volatile LAS unsigned* st_ = (volatile LAS unsigned*)(lds + 131072);
    if (threadIdx.x == 0) { st_[0] = 0u; st_[1] = 0u; }
    __syncthreads();
    const XcdBarrier xb_ = xcd_barrier_post((unsigned*)(ws + WS_BAR), st_);
#ifndef PHMASK
#define PHMASK 0x1fff
#endif
#define IN(k) (((PHMASK >> (k)) & 1) && p.lo <= (k) && (k) < p.hi)
#ifndef DUPMASK
#define DUPMASK 0
#endif
#define REPS(k) for (int rep_ = 0; rep_ < 1 + ((DUPMASK >> (k)) & 1); ++rep_)
#define RSYNC() do { if (rep_) xcd_barrier(xb_); } while (0)
#define SEAM(k) do { if (IN(k) && IN((k) + 1)) xcd_barrier(xb_); } while (0)
    if (p.lo > 1000) grid_sync_cg();
    if (IN(0)) REPS(0) { RSYNC(); ph_prep(p, lds); }
    SEAM(0);
    if (IN(1)) REPS(1) { RSYNC();
        { pg8::Gemm g{(const bf16_t*)(ws + WS_A), (const bf16_t*)(ws + WS_WIN), NTOK, 3840, 1024}; pg8::StaticOrder S; S.init(NTOK, 3840, G, bid);
          EpiWin E{(bf16_t*)(ws + WS_PHG), (bf16_t*)(ws + WS_PRW), (const float*)(ws + WS_RS0), p.out + O_PSH, p.out + O_SSH}; pg8::gemm_phase(lds, g, S, E); }
        { pg8::Gemm g{(const bf16_t*)(ws + WS_MEMB), (const bf16_t*)(ws + WS_WKV), 2048, 2048, 1024}; pg8::StaticOrder S; S.init(2048, 2048, G, (bid + G - 160 % G) % G);
          EpiMemKV E{p.out + O_PMK, p.out + O_PMV, (const float*)(ws + WS_RSM)}; pg8::gemm_phase(lds, g, S, E); }
    }
    SEAM(1);
    if (IN(2)) { ph_rwprep(p); ph_kvconv(p, lds); ph_hgprep(p, lds); }
    SEAM(2);
    if (IN(3)) {
        const bool split = (G == 256);
        pg8::Gemm g{(const bf16_t*)(ws + WS_B), (const bf16_t*)(ws + WS_WLORA), NTOK, 1536, 256}; pg8::StaticOrder S;
        EpiLora E{p.out, (bf16_t*)((unsigned char*)p.out + 68157440), (bf16_t*)((unsigned char*)p.out + 68157440 + HALF512), (bf16_t*)(ws + WS_PRW), (bf16_t*)(ws + WS_PRW + HALF512),
                  (const bf16_t*)(ws + WS_B + 17039360), (const float*)(ws + WS_KKN), p.in[13], p.in[15], p.in[18], p.in[19]};
        if (!split) { S.init(NTOK, 1536, G, bid); pg8::gemm_phase(lds, g, S, E); __syncthreads(); ph_hgseq(p, lds, 0, G); }
        else {
            if (bid < 128) { S.init(NTOK, 1536, 128, bid); S.window(0, 640); }
            else { ph_hgseq(p, lds, 128, 128); __syncthreads(); S.init(NTOK, 1536, 128, bid - 128); S.window(640, 780); }
            pg8::gemm_phase(lds, g, S, E);
        }
    }
    SEAM(3);
    if (IN(4)) REPS(4) { RSYNC(); ph_scan(p, lds); }
    SEAM(4);
    if (IN(5)) ph_rwpost(p);
    SEAM(5);
    if (IN(6)) {
        sgemm_sample<0>(lds, (const bf16_t*)(ws + WS_B), (const bf16_t*)(ws + WS_WOUT), 1024, p.in[2], p.out, (bf16_t*)(ws + WS_PRW), (float*)(ws + WS_SSQ1), nullptr);
        pg8::Gemm g{(const bf16_t*)(ws + WS_B), (const bf16_t*)(ws + WS_WOUT), NTOKP, 1024, 1024}; pg8::StaticOrder S; S.init(NTOKP, 1024, G, bid);
        EpiRes E{p.in[0], p.in[2], p.out, (bf16_t*)(ws + WS_PRW), (float*)(ws + WS_SSQ1)}; pg8::gemm_phase(lds, g, S, E);
    }
    SEAM(6);
    if (IN(7)) {
        sgemm_sample<1>(lds, (const bf16_t*)(ws + WS_PRW), (const bf16_t*)(ws + WS_WCQ), 1024, nullptr, nullptr, (bf16_t*)(ws + WS_A), nullptr, (const float*)(ws + WS_SSQ1));
        pg8::Gemm g{(const bf16_t*)(ws + WS_PRW), (const bf16_t*)(ws + WS_WCQ), NTOKP, 1024, 1024}; pg8::StaticOrder S; S.init(NTOKP, 1024, G, bid);
        EpiQ E{(bf16_t*)(ws + WS_A), (const float*)(ws + WS_SSQ1)}; pg8::gemm_phase(lds, g, S, E);
    }
    SEAM(7);
    if (IN(8)) REPS(8) { RSYNC(); ph_attn(p, lds); }
    SEAM(8);
    if (IN(9)) {
        sgemm_sample<0>(lds, (const bf16_t*)(ws + WS_B), (const bf16_t*)(ws + WS_WCO), 1024, p.out + (size_t)NTOKP * D, p.out, (bf16_t*)(ws + WS_A), (float*)(ws + WS_SSQ2), nullptr);
        pg8::Gemm g{(const bf16_t*)(ws + WS_B), (const bf16_t*)(ws + WS_WCO), NTOKP, 1024, 1024}; pg8::StaticOrder S; S.init(NTOKP, 1024, G, bid);
        EpiRes E{p.out, p.out + (size_t)NTOKP * D, p.out, (bf16_t*)(ws + WS_A), (float*)(ws + WS_SSQ2)}; pg8::gemm_phase(lds, g, S, E);
    }
    SEAM(9);
    if (IN(10)) REPS(10) { RSYNC();
        pg8::Gemm g{(const bf16_t*)(ws + WS_A), (const bf16_t*)(ws + WS_WFF13), NTOK, 5632, 1024}; pg8::StaticOrder S; S.init(NTOK, 5632, G, bid);
        EpiFF13 E{(bf16_t*)(ws + WS_PHG), (const float*)(ws + WS_SSQ2)}; pg8::gemm_phase(lds, g, S, E);
    }
    SEAM(10);
    if (IN(11)) {
        sgemm_sample<0>(lds, (const bf16_t*)(ws + WS_PHG), (const bf16_t*)(ws + WS_WFF2), 2816, p.out + (size_t)NTOKP * D, p.out, nullptr, nullptr, nullptr);
        pg8::Gemm g{(const bf16_t*)(ws + WS_PHG), (const bf16_t*)(ws + WS_WFF2), NTOKP, 1024, 2816}; pg8::StaticOrder S; S.init(NTOKP, 1024, G, bid);
        EpiRes E{p.out, p.out + (size_t)NTOKP * D, p.out, nullptr, nullptr}; pg8::gemm_phase(lds, g, S, E);
    }
    SEAM(11);
    if (IN(12)) ph_final(p);
#undef IN
#undef SEAM
}

extern "C" void kernel_launch(void* const* d_in, const int* in_sizes, int n_in, void* d_out, int out_size, void* d_ws, size_t ws_size, hipStream_t stream) {
    static int grid = 0;
    if (grid == 0) {
        if (n_in != 35 || ws_size < WS_END) { fprintf(stderr, "kernel_launch: unexpected n_in %d or ws %zu < %zu\n", n_in, ws_size, (size_t)WS_END); grid = -1; return; }
        if (hipFuncSetAttribute((const void*)mk_fwd, hipFuncAttributeMaxDynamicSharedMemorySize, LDS_BYTES) != hipSuccess) { fprintf(stderr, "kernel_launch: hipFuncSetAttribute failed\n"); grid = -1; return; }
        int dev = 0, cus = 0, per_cu = 0;
        hipGetDevice(&dev); hipDeviceGetAttribute(&cus, hipDeviceAttributeMultiprocessorCount, dev);
        hipOccupancyMaxActiveBlocksPerMultiprocessor(&per_cu, (const void*)mk_fwd, 512, LDS_BYTES);
        (void)hipGetLastError();
        if (per_cu < 1) per_cu = 1;
        grid = cus > 0 ? cus : 256;
    }
    if (grid < 0) return;
    if (hipMemsetAsync((char*)d_ws + WS_BAR, 0, 14080, stream) != hipSuccess) { fprintf(stderr, "kernel_launch: memset of the barrier word failed\n"); return; }
    Params p{};
    for (int i = 0; i < 35; ++i) p.in[i] = (const float*)d_in[i];
    p.out = (float*)d_out; p.ws = (unsigned char*)d_ws;
#if MK_MULTI
    for (int ph = 0; ph < NPHASE; ++ph) { p.lo = ph; p.hi = ph + 1; hipLaunchKernelGGL(mk_fwd, dim3(grid), dim3(512), LDS_BYTES, stream, p); }
#else
    p.lo = 0; p.hi = NPHASE;
    void* args[] = {&p};
    hipError_t e = hipLaunchCooperativeKernel((const void*)mk_fwd, dim3(grid), dim3(512), args, LDS_BYTES, stream);
    if (e != hipSuccess) fprintf(stderr, "cooperative launch failed: %s (grid %d)\n", hipGetErrorString(e), grid);
#endif
}
```

```cpp
#include <hip/hip_runtime.h>
#include <hip/hip_cooperative_groups.h>
#include <cstdio>
namespace cg = cooperative_groups;

#ifndef MK_MULTI
#define MK_MULTI 0
#endif

#define LAS __attribute__((address_space(3)))
typedef unsigned short bf16_t;
typedef short bf16x8 __attribute__((ext_vector_type(8)));
typedef float f32x4 __attribute__((ext_vector_type(4)));
typedef float f32x2 __attribute__((ext_vector_type(2)));
typedef unsigned u32x4 __attribute__((ext_vector_type(4)));
typedef unsigned u32x2 __attribute__((ext_vector_type(2)));

constexpr int D = 1024, NTOKP = 32768, NTOKS = 512, NTOK = 33280, HGC = 2048, RWC = 1792, DFF = 2816;
constexpr int NPHASE = 13;
constexpr int LDS_BYTES = 131072 + 16;

constexpr size_t O_Y = 0, O_PHG = 34078720, O_PRW = 34603008, O_PSH = 34865152, O_PMK = 34879488, O_PMV = 36976640,
                 O_SHG = 39073792, O_SRW = 40122368, O_SSH = 40646656;
constexpr size_t WS_WIN = 0;
constexpr size_t WS_WLORA = WS_WIN + 7864320;
constexpr size_t WS_WOUT = WS_WLORA + 786432;
constexpr size_t WS_WCQ = WS_WOUT + 2097152;
constexpr size_t WS_WKV = WS_WCQ + 2097152;
constexpr size_t WS_WCO = WS_WKV + 4194304;
constexpr size_t WS_WFF13 = WS_WCO + 2097152;
constexpr size_t WS_WFF2 = WS_WFF13 + 11534336;
constexpr size_t WS_PHG = WS_WFF2 + 5767168;
constexpr size_t WS_PRW = WS_PHG + 136314880;
constexpr size_t WS_A = WS_PRW + 119275520;
constexpr size_t WS_B = WS_A + 68157440;
constexpr size_t WS_MEMB = WS_B + 68157440;
constexpr size_t WS_KB = WS_MEMB + 4194304;
constexpr size_t WS_VT = WS_KB + 12582912;
constexpr size_t WS_RS0 = WS_VT + 12582912;
constexpr size_t WS_RSM = WS_RS0 + 133120;
constexpr size_t WS_KKN = WS_RSM + 8192;
constexpr size_t WS_SSQ1 = WS_KKN + 1064960;
constexpr size_t WS_SSQ2 = WS_SSQ1 + 2129920;
constexpr size_t WS_OI = WS_SSQ2 + 2129920;
constexpr size_t WS_DECB = WS_OI + 34078720;
constexpr size_t WS_BAR = WS_DECB + 1081344;
constexpr size_t WS_END = WS_BAR + 14080;
constexpr size_t HALF512 = 34078720;

struct Params {
    const float* in[35];
    float* out;
    unsigned char* ws;
    int lo, hi;
};

typedef __bf16 bf16x2_t __attribute__((ext_vector_type(2)));
__device__ __forceinline__ unsigned cvt_pk_bf16(float lo, float hi) { f32x2 f = {lo, hi}; bf16x2_t v = __builtin_convertvector(f, bf16x2_t); return __builtin_bit_cast(unsigned, v); }
__device__ __forceinline__ float bf_lo(unsigned w) { return __uint_as_float(w << 16); }
__device__ __forceinline__ float bf_hi(unsigned w) { return __uint_as_float(w & 0xffff0000u); }
__device__ __forceinline__ float bf1(bf16_t b) { return __uint_as_float(((unsigned)b) << 16); }
__device__ __forceinline__ bf16_t f2bf(float f) { return (bf16_t)(cvt_pk_bf16(f, 0.f) & 0xffffu); }
__device__ __forceinline__ float sigmoidf_(float x) { return __builtin_amdgcn_rcpf(1.0f + __expf(-x)); }
__device__ __forceinline__ void unpack8(const u32x4 w, float* f) {
    f[0] = bf_lo(w.x); f[1] = bf_hi(w.x); f[2] = bf_lo(w.y); f[3] = bf_hi(w.y); f[4] = bf_lo(w.z); f[5] = bf_hi(w.z); f[6] = bf_lo(w.w); f[7] = bf_hi(w.w);
}
__device__ __forceinline__ u32x4 pack8(const float* f) {
    u32x4 w; w.x = cvt_pk_bf16(f[0], f[1]); w.y = cvt_pk_bf16(f[2], f[3]); w.z = cvt_pk_bf16(f[4], f[5]); w.w = cvt_pk_bf16(f[6], f[7]); return w;
}
__device__ __forceinline__ int opaque_tid() { int t = threadIdx.x; asm volatile("" : "+v"(t)); return t; }
template <int CTRL> __device__ __forceinline__ float dppf(float x) {
    return __int_as_float(__builtin_amdgcn_update_dpp(0, __float_as_int(x), CTRL, 0xf, 0xf, true));
}
__device__ __forceinline__ float red4(float x) { x += dppf<0xB1>(x); x += dppf<0x4E>(x); return x; }
__device__ __forceinline__ float red8(float x) { x = red4(x); x += dppf<0x141>(x); return x; }
__device__ __forceinline__ float red16(float x) { x = red8(x); x += dppf<0x140>(x); return x; }
__device__ __forceinline__ float red64(float x) { x = red16(x); x += __shfl_xor(x, 16); x += __shfl_xor(x, 32); return x; }

namespace pg8 {
constexpr int BM = 256, BK = 64, HALF = 128, HTB = HALF * BK * 2, STAGE_BYTES = 8 * HTB, NXCD = 8, WGM = 8;
__device__ __forceinline__ int lds_byte(int r, int c) { const int st = (r >> 4) * 2 + (c >> 5), rr = r & 15, cc = c & 31, ob = rr * 64 + cc * 2; return st * 1024 + (ob ^ (((ob >> 9) & 1) << 5)); }
__device__ __forceinline__ void stage_rc(int b, int& R, int& C) { const int st = b / 1024, sb = b % 1024, swz = sb ^ (((sb >> 9) & 1) << 5); R = (st >> 1) * 16 + swz / 64; C = (st & 1) * 32 + (swz % 64) / 2; }
__device__ __forceinline__ int perm32(int rho) { const int n = rho >> 4, i = rho & 15; return 8 * (i >> 2) + 4 * n + (i & 3); }
struct Unit { int pm, pn; };
struct Gemm { const bf16_t* A; const bf16_t* Bt; int M, N, K; };
struct StaticOrder {
    int nM, nN, nwg, G, c, base, cap;
    __device__ __forceinline__ void init(int M, int N, int G_, int c_) { nM = M / BM; nN = N / BM; nwg = nM * nN; G = G_; c = c_; base = 0; cap = nwg; }
    __device__ __forceinline__ void window(int base_, int cap_) { base = base_; cap = cap_ < nwg ? cap_ : nwg; }
    __device__ bool next(int i, Unit& u) const {
        const long L = (long)base + (long)i * G + c; if (L >= cap) return false;
        int wgid = (int)L; { const int q = nwg / NXCD, r = nwg % NXCD, xcd = wgid % NXCD, off = wgid / NXCD; wgid = (xcd < r ? xcd * (q + 1) : r * (q + 1) + (xcd - r) * q) + off; }
        const int nig = WGM * nN, gid = wgid / nig, fm = gid * WGM, gsz = (nM - fm) < WGM ? (nM - fm) : WGM;
        u.pm = fm + ((wgid % nig) % gsz); u.pn = (wgid % nig) / gsz; return true;
    }
};
template <class Epi, bool ALIGN_EPI = true, bool SP2 = true>
__device__ __forceinline__ void gemm_phase(LAS unsigned char* lds, const Gemm g, const StaticOrder& S, const Epi& E) {
    const int tid = opaque_tid(), wid = __builtin_amdgcn_readfirstlane(tid >> 6), lane = tid & 63, wr = wid >> 2, wc = wid & 3, fr = lane & 15, fq = lane >> 4;
    const int K = g.K, nt = K / BK;
    unsigned voffA[2], voffB[2];
#pragma unroll
    for (int i = 0; i < 2; ++i) { int R, C; stage_rc(tid * 16 + i * 8192, R, C); const int Rb = Epi::PERM ? ((R & ~31) + perm32(R & 31)) : R;
        voffA[i] = (unsigned)(R * K + C) * 2u; voffB[i] = (unsigned)(Rb * K + C) * 2u; }
    const size_t kstep = (size_t)(BK * 2);
    const size_t hstep = (size_t)HALF * K * 2;
    const size_t tstep = 2 * hstep;
    const unsigned ldsw = (unsigned)wid * 1024u;
    const int aoff = lds_byte(wr * 64 + fr, fq * 8), boff = lds_byte(wc * 32 + fr, fq * 8);
#define PG8_SA(b, h) (((b) * 2 + (h)) * HTB)
#define PG8_SB(b, h) ((4 + (b) * 2 + (h)) * HTB)
#define PG8_STAGE(bufoff, gbase, voff) do { _Pragma("unroll") for (int _i = 0; _i < 2; ++_i) \
        __builtin_amdgcn_global_load_lds((const unsigned*)((const char*)(gbase) + (voff)[_i]), (LAS unsigned*)(lds + (bufoff) + ldsw + _i * 8192), 16, 0, 0); } while (0)
#define PG8_LDA(dst, b, h) do { _Pragma("unroll") for (int m = 0; m < 4; ++m) _Pragma("unroll") for (int k = 0; k < 2; ++k) dst[m][k] = *(const LAS bf16x8*)(lds + PG8_SA(b, h) + aoff + m * 2048 + k * 1024); } while (0)
#define PG8_LDB(dst, b, h) do { _Pragma("unroll") for (int n = 0; n < 2; ++n) _Pragma("unroll") for (int k = 0; k < 2; ++k) dst[n][k] = *(const LAS bf16x8*)(lds + PG8_SB(b, h) + boff + n * 2048 + k * 1024); } while (0)
#define PG8_MMA(ai, bj, At, Bt) do { __builtin_amdgcn_s_setprio(1); _Pragma("unroll") for (int m = 0; m < 4; ++m) _Pragma("unroll") for (int n = 0; n < 2; ++n) _Pragma("unroll") for (int k = 0; k < 2; ++k) \
        acc[ai][bj][m][n] = __builtin_amdgcn_mfma_f32_16x16x32_bf16(Bt[n][k], At[m][k], acc[ai][bj][m][n], 0, 0, 0); __builtin_amdgcn_s_setprio(0); } while (0)
#define PG8_WAIT_V(n) asm volatile("s_waitcnt vmcnt(" #n ")" ::: "memory")
#define PG8_WAIT_L(n) asm volatile("s_waitcnt lgkmcnt(" #n ")" ::: "memory")
#define PG8_BAR __builtin_amdgcn_s_barrier()
#define PG8_SCHED __builtin_amdgcn_sched_barrier(0)
    Unit cur, nxt; int ui = 0;
    if (!S.next(0, cur)) return;
    f32x4 acc[2][2][4][2];
#pragma unroll
    for (int a = 0; a < 2; ++a)
#pragma unroll
        for (int b = 0; b < 2; ++b)
#pragma unroll
            for (int m = 0; m < 4; ++m)
#pragma unroll
                for (int n = 0; n < 2; ++n) acc[a][b][m][n] = (f32x4){0.f, 0.f, 0.f, 0.f};
    bf16x8 At[4][2], B0[2][2], B1[2][2];
    const char* cA = (const char*)g.A + (size_t)cur.pm * tstep; const char* cB = (const char*)g.Bt + (size_t)cur.pn * tstep;
    if constexpr (SP2) {
        PG8_STAGE(PG8_SB(0, 0), cB, voffB); PG8_STAGE(PG8_SB(0, 1), cB + hstep, voffB); PG8_STAGE(PG8_SA(0, 0), cA, voffA); PG8_STAGE(PG8_SA(0, 1), cA + hstep, voffA);
        if (wr == 1) PG8_BAR;
        PG8_WAIT_V(2); PG8_BAR;
        PG8_STAGE(PG8_SB(1, 0), cB + kstep, voffB); PG8_STAGE(PG8_SA(1, 0), cA + kstep, voffA); PG8_STAGE(PG8_SB(1, 1), cB + hstep + kstep, voffB);
        PG8_WAIT_V(6); PG8_BAR;
    } else {
        PG8_STAGE(PG8_SB(0, 0), cB, voffB); PG8_STAGE(PG8_SA(0, 0), cA, voffA); PG8_STAGE(PG8_SB(0, 1), cB + hstep, voffB); PG8_STAGE(PG8_SA(0, 1), cA + hstep, voffA);
        if (wr == 1) PG8_BAR;
        PG8_WAIT_V(4); PG8_BAR;
        PG8_STAGE(PG8_SB(1, 0), cB + kstep, voffB); PG8_STAGE(PG8_SA(1, 0), cA + kstep, voffA); PG8_STAGE(PG8_SB(1, 1), cB + hstep + kstep, voffB);
        PG8_WAIT_V(6); PG8_BAR;
    }
    for (;;) {
        const bool has_next = S.next(ui + 1, nxt);
        const char* nA = has_next ? (const char*)g.A + (size_t)nxt.pm * tstep : cA; const char* nB = has_next ? (const char*)g.Bt + (size_t)nxt.pn * tstep : cB;
#pragma unroll 1
        for (int t = 0; t < nt; t += 2) {
            const bool last = (t == nt - 2);
            const char* a1 = cA + (size_t)(t + 1) * kstep;
            const char* a2 = last ? nA : cA + (size_t)(t + 2) * kstep; const char* b2 = last ? nB : cB + (size_t)(t + 2) * kstep;
            const char* a3 = a2 + kstep; const char* b3 = b2 + kstep;
            if constexpr (SP2) {
            PG8_LDB(B0, 0, 0); PG8_LDB(B1, 0, 1); PG8_SCHED; PG8_LDA(At, 0, 0); PG8_STAGE(PG8_SA(1, 1), a1 + hstep, voffA);
            PG8_WAIT_V(8); PG8_WAIT_L(0); PG8_BAR; PG8_MMA(0, 0, At, B0); PG8_MMA(0, 1, At, B1); PG8_BAR; PG8_SCHED;
            PG8_LDA(At, 0, 1); PG8_STAGE(PG8_SB(0, 0), b2, voffB); PG8_STAGE(PG8_SB(0, 1), b2 + hstep, voffB); PG8_STAGE(PG8_SA(0, 0), a2, voffA);
            PG8_WAIT_V(8); PG8_WAIT_L(0); PG8_BAR; PG8_MMA(1, 0, At, B0); PG8_MMA(1, 1, At, B1); PG8_BAR; PG8_SCHED;
            PG8_LDB(B0, 1, 0); PG8_LDB(B1, 1, 1); PG8_SCHED; PG8_LDA(At, 1, 0); PG8_STAGE(PG8_SA(0, 1), a2 + hstep, voffA);
            PG8_WAIT_V(8); PG8_WAIT_L(0); PG8_BAR; PG8_MMA(0, 0, At, B0); PG8_MMA(0, 1, At, B1); PG8_BAR; PG8_SCHED;
            PG8_LDA(At, 1, 1); PG8_STAGE(PG8_SB(1, 0), b3, voffB); PG8_STAGE(PG8_SB(1, 1), b3 + hstep, voffB); PG8_STAGE(PG8_SA(1, 0), a3, voffA);
            PG8_WAIT_V(8); PG8_WAIT_L(0); PG8_BAR; PG8_MMA(1, 0, At, B0); PG8_MMA(1, 1, At, B1); PG8_BAR; PG8_SCHED;
            } else {
            PG8_LDB(B0, 0, 0); PG8_SCHED; PG8_LDA(At, 0, 0); PG8_STAGE(PG8_SA(1, 1), a1 + hstep, voffA);
            PG8_WAIT_L(8); PG8_BAR; PG8_WAIT_L(0); PG8_MMA(0, 0, At, B0); PG8_BAR; PG8_SCHED;
            PG8_LDB(B1, 0, 1); PG8_STAGE(PG8_SB(0, 0), b2, voffB);
            PG8_BAR; PG8_WAIT_L(0); PG8_MMA(0, 1, At, B1); PG8_BAR;
            PG8_LDA(At, 0, 1); PG8_STAGE(PG8_SA(0, 0), a2, voffA);
            PG8_BAR; PG8_WAIT_L(0); PG8_MMA(1, 0, At, B0); PG8_BAR; PG8_SCHED;
            PG8_STAGE(PG8_SB(0, 1), b2 + hstep, voffB);
            PG8_WAIT_V(6); PG8_BAR; PG8_MMA(1, 1, At, B1); PG8_BAR;
            PG8_LDB(B0, 1, 0); PG8_SCHED; PG8_LDA(At, 1, 0); PG8_STAGE(PG8_SA(0, 1), a2 + hstep, voffA);
            PG8_WAIT_L(8); PG8_BAR; PG8_WAIT_L(0); PG8_MMA(0, 0, At, B0); PG8_BAR; PG8_SCHED;
            PG8_LDB(B1, 1, 1); PG8_STAGE(PG8_SB(1, 0), b3, voffB);
            PG8_BAR; PG8_WAIT_L(0); PG8_MMA(0, 1, At, B1); PG8_BAR;
            PG8_LDA(At, 1, 1); PG8_STAGE(PG8_SA(1, 0), a3, voffA);
            PG8_BAR; PG8_WAIT_L(0); PG8_MMA(1, 0, At, B0); PG8_BAR; PG8_SCHED;
            PG8_STAGE(PG8_SB(1, 1), b3 + hstep, voffB);
            PG8_WAIT_V(6); PG8_BAR; PG8_MMA(1, 1, At, B1); PG8_BAR;
            }
        }
        if constexpr (ALIGN_EPI) { if (wr == 0) PG8_BAR; }
        E(acc, cur, wr, wc, fr, fq);
        if (!has_next) break;
#pragma unroll
        for (int a = 0; a < 2; ++a)
#pragma unroll
            for (int b = 0; b < 2; ++b)
#pragma unroll
                for (int m = 0; m < 4; ++m)
#pragma unroll
                    for (int n = 0; n < 2; ++n) acc[a][b][m][n] = (f32x4){0.f, 0.f, 0.f, 0.f};
        cur = nxt; cA = nA; cB = nB; ++ui;
        if constexpr (ALIGN_EPI) { if (wr == 1) PG8_BAR; }
    }
    PG8_WAIT_V(0);
    if constexpr (!ALIGN_EPI) { if (wr == 0) PG8_BAR; }
    PG8_BAR;
#undef PG8_SA
#undef PG8_SB
#undef PG8_STAGE
#undef PG8_LDA
#undef PG8_LDB
#undef PG8_MMA
#undef PG8_WAIT_V
#undef PG8_WAIT_L
#undef PG8_BAR
#undef PG8_SCHED
}
}
using pg8::Unit;

__device__ __forceinline__ u32x4 pack_acc8(const f32x4 a, const f32x4 b, float s) {
    u32x4 w; w.x = cvt_pk_bf16(a[0] * s, a[1] * s); w.y = cvt_pk_bf16(a[2] * s, a[3] * s); w.z = cvt_pk_bf16(b[0] * s, b[1] * s); w.w = cvt_pk_bf16(b[2] * s, b[3] * s); return w;
}
__device__ __forceinline__ float rs_from_parts(const float* sp) {
    const f32x4 a = *(const f32x4*)sp, b = *(const f32x4*)(sp + 4), c = *(const f32x4*)(sp + 8), d = *(const f32x4*)(sp + 12);
    const float s = ((a[0] + a[1]) + (a[2] + a[3])) + ((b[0] + b[1]) + (b[2] + b[3])) + ((c[0] + c[1]) + (c[2] + c[3])) + ((d[0] + d[1]) + (d[2] + d[3]));
    return rsqrtf(s * (1.0f / 1024.0f) + 1e-6f);
}

__device__ __forceinline__ float rs_from_parts4(const float* sp, int fq) {
    const f32x4 a = *(const f32x4*)(sp + fq * 4); float s = (a[0] + a[1]) + (a[2] + a[3]);
    s += __shfl_xor(s, 16); s += __shfl_xor(s, 32);
    return rsqrtf(s * (1.0f / 1024.0f) + 1e-6f);
}
struct EpiWin {
    static constexpr bool PERM = true;
    bf16_t* phg; bf16_t* prw; const float* rs0; float* psh; float* ssh;
    __device__ __forceinline__ void operator()(const f32x4 (&acc)[2][2][4][2], const Unit& u, int wr, int wc, int fr, int fq) const {
        const int row0 = u.pm * 256 + wr * 64 + fr;
        const bool hg = u.pn < 8; bf16_t* base = hg ? phg : prw; const int ld = hg ? HGC : RWC; const int col0 = (hg ? u.pn : u.pn - 8) * 256 + wc * 32 + 8 * fq;
        float sv[8];
#pragma unroll
        for (int i = 0; i < 8; ++i) sv[i] = rs0[row0 + (i >> 2) * 128 + (i & 3) * 16];
#pragma unroll
        for (int ai = 0; ai < 2; ++ai)
#pragma unroll
            for (int m = 0; m < 4; ++m) {
                const int row = row0 + ai * 128 + m * 16; const float s = sv[ai * 4 + m]; bf16_t* rowp = base + (size_t)row * ld + col0;
#pragma unroll
                for (int bj = 0; bj < 2; ++bj) *(u32x4*)(rowp + bj * 128) = pack_acc8(acc[ai][bj][m][0], acc[ai][bj][m][1], s);
                if (!hg) {
                    bool last; float* dst;
                    if (row < NTOKP) { last = (row & 4095) == 4095; dst = psh + (row >> 12) * RWC; } else { const int rr = row - NTOKP; last = (rr & 31) == 31; dst = ssh + (rr >> 5) * RWC; }
                    if (last) {
#pragma unroll
                        for (int bj = 0; bj < 2; ++bj) { *(f32x4*)(dst + col0 + bj * 128) = acc[ai][bj][m][0] * s; *(f32x4*)(dst + col0 + bj * 128 + 4) = acc[ai][bj][m][1] * s; }
                    }
                }
            }
    }
};
struct EpiMemKV {
    static constexpr bool PERM = false;
    float* pmk; float* pmv; const float* rsm;
    __device__ __forceinline__ void operator()(const f32x4 (&acc)[2][2][4][2], const Unit& u, int wr, int wc, int fr, int fq) const {
        const int row0 = u.pm * 256 + wr * 64 + fr; const bool isk = u.pn < 4; float* base = isk ? pmk : pmv; const int col0 = (isk ? u.pn : u.pn - 4) * 256 + wc * 32 + 4 * fq;
        float sv[8];
#pragma unroll
        for (int i = 0; i < 8; ++i) sv[i] = rsm[row0 + (i >> 2) * 128 + (i & 3) * 16];
#pragma unroll
        for (int ai = 0; ai < 2; ++ai)
#pragma unroll
            for (int m = 0; m < 4; ++m) {
                const int row = row0 + ai * 128 + m * 16; const float s = sv[ai * 4 + m]; float* rowp = base + (size_t)row * D + col0;
#pragma unroll
                for (int bj = 0; bj < 2; ++bj)
#pragma unroll
                    for (int n = 0; n < 2; ++n) *(f32x4*)(rowp + bj * 128 + n * 16) = acc[ai][bj][m][n] * s;
            }
    }
};
struct EpiLora {
    static constexpr bool PERM = true;
    float* decay; bf16_t* kk; bf16_t* kka; bf16_t* kp; bf16_t* g; const bf16_t* xk; const float* kkn; const float* w0; const float* a0; const float* k_k; const float* k_a;
    __device__ __forceinline__ void operator()(const f32x4 (&acc)[2][2][4][2], const Unit& u, int wr, int wc, int fr, int fq) const {
        const int row0 = u.pm * 256 + wr * 64 + fr; const int type = u.pn >> 1; const int cb = (u.pn & 1) * 256 + wc * 32 + 8 * fq;
        if (type == 0) {
            float wv[2][8];
#pragma unroll
            for (int bj = 0; bj < 2; ++bj)
#pragma unroll
                for (int j = 0; j < 8; ++j) wv[bj][j] = w0[cb + bj * 128 + j];
#pragma unroll
            for (int ai = 0; ai < 2; ++ai)
#pragma unroll
                for (int m = 0; m < 4; ++m) {
                    const int row = row0 + ai * 128 + m * 16;
#pragma unroll
                    for (int bj = 0; bj < 2; ++bj) {
                        const size_t o = (size_t)row * 512 + cb + bj * 128; float d[8];
#pragma unroll
                        for (int j = 0; j < 8; ++j) { const float v = j < 4 ? acc[ai][bj][m][0][j] : acc[ai][bj][m][1][j - 4]; d[j] = __expf(-0.60653066f * sigmoidf_(wv[bj][j] + v)); }
                        *(f32x4*)(decay + o) = (f32x4){d[0], d[1], d[2], d[3]}; *(f32x4*)(decay + o + 4) = (f32x4){d[4], d[5], d[6], d[7]};
                    }
                }
        } else if (type == 1) {
#pragma unroll
            for (int ai = 0; ai < 2; ++ai)
#pragma unroll
                for (int mh = 0; mh < 2; ++mh) {
                    u32x4 xw[2][2]; float nr[2][2];
#pragma unroll
                    for (int m2 = 0; m2 < 2; ++m2) { const int row = row0 + ai * 128 + (mh * 2 + m2) * 16;
#pragma unroll
                        for (int bj = 0; bj < 2; ++bj) { xw[m2][bj] = *(const u32x4*)(xk + (size_t)row * 512 + cb + bj * 128); nr[m2][bj] = kkn[row * 8 + ((cb + bj * 128) >> 6)]; } }
#pragma unroll
                    for (int m2 = 0; m2 < 2; ++m2) { const int m = mh * 2 + m2; const int row = row0 + ai * 128 + m * 16;
#pragma unroll
                        for (int bj = 0; bj < 2; ++bj) {
                            const int c = cb + bj * 128; const size_t o = (size_t)row * 512 + c; float x[8], k1[8], k2[8], k3[8]; unpack8(xw[m2][bj], x);
#pragma unroll
                            for (int j = 0; j < 8; ++j) { const float v = j < 4 ? acc[ai][bj][m][0][j] : acc[ai][bj][m][1][j - 4]; const float a = sigmoidf_(a0[c + j] + v); const float kq = x[j] * k_k[c + j] * nr[m2][bj]; k1[j] = kq; k2[j] = kq * a; k3[j] = x[j] * (1.0f + (a - 1.0f) * k_a[c + j]); }
                            *(u32x4*)(kk + o) = pack8(k1); *(u32x4*)(kka + o) = pack8(k2); *(u32x4*)(kp + o) = pack8(k3);
                        } }
                }
        } else {
#pragma unroll
            for (int ai = 0; ai < 2; ++ai)
#pragma unroll
                for (int m = 0; m < 4; ++m) {
                    const int row = row0 + ai * 128 + m * 16;
#pragma unroll
                    for (int bj = 0; bj < 2; ++bj) *(u32x4*)(g + (size_t)row * 512 + cb + bj * 128) = pack_acc8(acc[ai][bj][m][0], acc[ai][bj][m][1], 1.0f);
                }
        }
    }
};
struct EpiRes {
    static constexpr bool PERM = false;
    const float* rp; const float* rs; float* out; bf16_t* xb; float* ssq;
    __device__ __forceinline__ void operator()(const f32x4 (&acc)[2][2][4][2], const Unit& u, int wr, int wc, int fr, int fq) const {
        const int row0 = u.pm * 256 + wr * 64 + fr; const int col0 = u.pn * 256 + wc * 32 + 4 * fq;
#pragma unroll
        for (int ai = 0; ai < 2; ++ai) {
            f32x4 rr[4][2][2];
#pragma unroll
            for (int m = 0; m < 4; ++m) {
                const int row = row0 + ai * 128 + m * 16;
                const float* rrow = (row < NTOKP ? rp + (size_t)row * D : rs + (size_t)(row - NTOKP) * D) + col0;
#pragma unroll
                for (int bj = 0; bj < 2; ++bj)
#pragma unroll
                    for (int n = 0; n < 2; ++n) rr[m][bj][n] = *(const f32x4*)(rrow + bj * 128 + n * 16);
            }
#pragma unroll
            for (int m = 0; m < 4; ++m) {
                const int row = row0 + ai * 128 + m * 16; float* orow = out + (size_t)row * D + col0; float ss = 0.f;
#pragma unroll
                for (int bj = 0; bj < 2; ++bj)
#pragma unroll
                    for (int n = 0; n < 2; ++n) {
                        const f32x4 x = rr[m][bj][n] + acc[ai][bj][m][n];
                        *(f32x4*)(orow + bj * 128 + n * 16) = x; ss += (x[0] * x[0] + x[1] * x[1]) + (x[2] * x[2] + x[3] * x[3]);
                        if (xb) { u32x2 w; w.x = cvt_pk_bf16(x[0], x[1]); w.y = cvt_pk_bf16(x[2], x[3]); *(u32x2*)(xb + (size_t)row * D + col0 + bj * 128 + n * 16) = w; }
                    }
                if (ssq) { ss += __shfl_xor(ss, 16); ss += __shfl_xor(ss, 32); if (fq == 0) ssq[row * 16 + u.pn * 4 + wc] = ss; }
            }
        }
    }
};
struct EpiQ {
    static constexpr bool PERM = true;
    bf16_t* q; const float* ssq;
    __device__ __forceinline__ void operator()(const f32x4 (&acc)[2][2][4][2], const Unit& u, int wr, int wc, int fr, int fq) const {
        const int row0 = u.pm * 256 + wr * 64 + fr; const int col0 = u.pn * 256 + wc * 32 + 8 * fq;
        float sv[8];
#pragma unroll
        for (int i = 0; i < 8; ++i) sv[i] = rs_from_parts4(ssq + (size_t)(row0 + (i >> 2) * 128 + (i & 3) * 16) * 16, fq) * 0.0625f;
#pragma unroll
        for (int ai = 0; ai < 2; ++ai)
#pragma unroll
            for (int m = 0; m < 4; ++m) {
                const int row = row0 + ai * 128 + m * 16; const float s = sv[ai * 4 + m]; bf16_t* rowp = q + (size_t)row * D + col0;
#pragma unroll
                for (int bj = 0; bj < 2; ++bj) *(u32x4*)(rowp + bj * 128) = pack_acc8(acc[ai][bj][m][0], acc[ai][bj][m][1], s);
            }
    }
};
struct EpiFF13 {
    static constexpr bool PERM = true;
    bf16_t* h; const float* ssq;
    __device__ __forceinline__ void operator()(const f32x4 (&acc)[2][2][4][2], const Unit& u, int wr, int wc, int fr, int fq) const {
        const int row0 = u.pm * 256 + wr * 64 + fr; const int col0 = u.pn * 128 + wc * 32 + 8 * fq;
        float sv[8];
#pragma unroll
        for (int i = 0; i < 8; ++i) sv[i] = rs_from_parts4(ssq + (size_t)(row0 + (i >> 2) * 128 + (i & 3) * 16) * 16, fq);
#pragma unroll
        for (int ai = 0; ai < 2; ++ai)
#pragma unroll
            for (int m = 0; m < 4; ++m) {
                const int row = row0 + ai * 128 + m * 16; const float s = sv[ai * 4 + m]; float o[8];
#pragma unroll
                for (int n = 0; n < 2; ++n)
#pragma unroll
                    for (int j = 0; j < 4; ++j) { const float a1 = acc[ai][0][m][n][j] * s, a3 = acc[ai][1][m][n][j] * s; o[n * 4 + j] = a1 * sigmoidf_(a1) * a3; }
                *(u32x4*)(h + (size_t)row * DFF + col0) = pack8(o);
            }
    }
};

template <int MODE>
__device__ __forceinline__ void sgemm_sample(LAS unsigned char* lds, const bf16_t* A, const bf16_t* Bt, int K, const float* resid, float* out, bf16_t* xb, float* ssq_out, const float* ssq_in) {
    const int tid = opaque_tid(), lane = tid & 63, w = __builtin_amdgcn_readfirstlane(tid >> 6), fr = lane & 15, fq = lane >> 4;
    const int u = blockIdx.x * 8 + w;
    const bool act = (gridDim.x == 256);
#pragma unroll 1
    for (int uu = u; uu < 2048; uu += gridDim.x * 8) {
        const int rt = uu >> 6, ct = uu & 63; const int row = NTOKP + rt * 16 + fr, col0 = ct * 16 + fq * 4;
        const bf16_t* ap = A + (size_t)row * K + fq * 8; const bf16_t* bp = Bt + (size_t)(ct * 16 + fr) * K + fq * 8;
        f32x4 acc = {0.f, 0.f, 0.f, 0.f};
#pragma unroll 8
        for (int ks = 0; ks < K / 32; ++ks) {
            const bf16x8 a = *(const bf16x8*)(ap + ks * 32); const bf16x8 b = *(const bf16x8*)(bp + ks * 32);
            acc = __builtin_amdgcn_mfma_f32_16x16x32_bf16(b, a, acc, 0, 0, 0);
        }
        if (MODE == 0) {
            const f32x4 x = *(const f32x4*)(resid + (size_t)(row - NTOKP) * D + col0) + acc;
            *(f32x4*)(out + (size_t)row * D + col0) = x;
            if (xb) { u32x2 wv; wv.x = cvt_pk_bf16(x[0], x[1]); wv.y = cvt_pk_bf16(x[2], x[3]); *(u32x2*)(xb + (size_t)row * D + col0) = wv; }
            if (ssq_out) {
                float ss = (x[0] * x[0] + x[1] * x[1]) + (x[2] * x[2] + x[3] * x[3]); ss += __shfl_xor(ss, 16); ss += __shfl_xor(ss, 32);
                if (fq == 0) *(LAS float*)(lds + (w * 16 + fr) * 4) = ss;
                __syncthreads();
                if (tid < 16) { float t = 0.f;
#pragma unroll
                    for (int i = 0; i < 8; ++i) t += *(const LAS float*)(lds + (i * 16 + tid) * 4);
                    const int g = (uu & 63) >> 3; float* sp = ssq_out + (size_t)(NTOKP + rt * 16 + tid) * 16; sp[g] = t; sp[8 + g] = 0.f; }
                __syncthreads();
            }
        } else {
            const float sc = rs_from_parts(ssq_in + (size_t)row * 16) * 0.0625f;
            u32x2 wv; wv.x = cvt_pk_bf16(acc[0] * sc, acc[1] * sc); wv.y = cvt_pk_bf16(acc[2] * sc, acc[3] * sc); *(u32x2*)(xb + (size_t)row * D + col0) = wv;
        }
    }
    (void)act;
    __syncthreads();
}

__device__ __forceinline__ void transpose_job(LAS float* tile, const float* src, int ldn, int K, int N, const float* gain, bf16_t* dst, int mode, int noff, int nbatch, size_t sstride, size_t dstride) {
    const int tid = opaque_tid(); const int tn = N / 64, tk = K / 64, per = tn * tk, total = per * nbatch;
    int t = blockIdx.x; if (t >= total) return;
    float v[8];
#define TR_LD(tt_) do { const int bb_ = (tt_) / per, t2_ = (tt_) % per; const int k0_ = (t2_ / tn) * 64, n0_ = (t2_ % tn) * 64; const float* s_ = src + (size_t)bb_ * sstride; \
        _Pragma("unroll") for (int i = 0; i < 8; ++i) { const int idx = tid + i * 512, kk = idx >> 6, nn = idx & 63; v[i] = s_[(size_t)(k0_ + kk) * ldn + n0_ + nn]; } \
        if (gain) { float g_[8]; _Pragma("unroll") for (int i = 0; i < 8; ++i) g_[i] = gain[k0_ + ((tid + i * 512) >> 6)]; _Pragma("unroll") for (int i = 0; i < 8; ++i) v[i] *= g_[i]; } } while (0)
    TR_LD(t);
#pragma unroll 1
    for (; t < total; t += gridDim.x) {
        const int bb = t / per, tt = t % per; const int k0 = (tt / tn) * 64, n0 = (tt % tn) * 64; bf16_t* d = dst + (size_t)bb * dstride;
#pragma unroll
        for (int i = 0; i < 8; ++i) { const int idx = tid + i * 512, kk = idx >> 6, nn = idx & 63; tile[kk * 65 + nn] = v[i]; }
        __syncthreads();
        if (t + (int)gridDim.x < total) TR_LD(t + (int)gridDim.x);
#pragma unroll
        for (int i = 0; i < 4; ++i) { const int idx = tid + i * 512, nn = idx >> 5, kp = idx & 31; const int n = n0 + nn;
            int r = n + noff; if (mode == 1) r = (n >> 7) * 256 + (n & 127); else if (mode == 2) r = (n >> 7) * 256 + 128 + (n & 127);
            *(unsigned*)(d + (size_t)r * K + k0 + 2 * kp) = cvt_pk_bf16(tile[(2 * kp) * 65 + nn], tile[(2 * kp + 1) * 65 + nn]); }
        __syncthreads();
    }
#undef TR_LD
}
__device__ __forceinline__ void transpose_wave(const float* src, int ldn, int K, int N, const float* gain, bf16_t* dst, int mode, int noff, int nbatch, size_t sstride, size_t dstride) {
    const int tid = opaque_tid(), lane = tid & 63, wid = tid >> 6; const int gw = blockIdx.x * 8 + wid, nw = gridDim.x * 8;
    const int tn = N / 64, tk = K / 64, per = tn * tk, total = per * nbatch;
#pragma unroll 1
    for (int t = gw; t < total; t += nw) {
        const int bb = t / per, tt = t - bb * per; const int k0 = (tt / tn) * 64, n0 = (tt % tn) * 64;
        const float* s_ = src + (size_t)bb * sstride + (size_t)k0 * ldn + n0 + lane; float v[64];
#pragma unroll
        for (int k = 0; k < 64; ++k) v[k] = s_[(size_t)k * ldn];
        if (gain) {
#pragma unroll
            for (int k = 0; k < 64; ++k) v[k] *= gain[k0 + k];
        }
        const int n = n0 + lane; int r = n + noff; if (mode == 1) r = (n >> 7) * 256 + (n & 127); else if (mode == 2) r = (n >> 7) * 256 + 128 + (n & 127);
        bf16_t* d = dst + (size_t)bb * dstride + (size_t)r * K + k0;
#pragma unroll
        for (int i = 0; i < 8; ++i) *(u32x4*)(d + i * 8) = pack8(v + i * 8);
    }
}
__device__ __forceinline__ void ph_prep(const Params& p, LAS unsigned char* lds) {
    const int tid = opaque_tid(), lane = tid & 63, wid = tid >> 6; const int gw = blockIdx.x * 8 + wid, nw = gridDim.x * 8;
    unsigned char* ws = p.ws;
    bf16_t* xb = (bf16_t*)(ws + WS_A); bf16_t* memb = (bf16_t*)(ws + WS_MEMB); float* rs0 = (float*)(ws + WS_RS0); float* rsm = (float*)(ws + WS_RSM);
    {
        const int TOT = NTOK + 2048; f32x4 cur[4], nxt[4];
#define RC_SRC(row) ((row) < NTOKP ? p.in[0] + (size_t)(row) * D : (row) < NTOK ? p.in[2] + (size_t)((row) - NTOKP) * D : p.in[1] + (size_t)((row) - NTOK) * D)
        int row = gw;
        if (row < TOT) { const f32x4* sp = (const f32x4*)RC_SRC(row);
#pragma unroll
            for (int i = 0; i < 4; ++i) cur[i] = sp[i * 64 + lane]; }
#pragma unroll 1
        for (; row < TOT; row += nw) {
            const int nr = row + nw;
            if (nr < TOT) { const f32x4* sp = (const f32x4*)RC_SRC(nr);
#pragma unroll
                for (int i = 0; i < 4; ++i) nxt[i] = sp[i * 64 + lane]; }
            float ss = 0.f;
#pragma unroll
            for (int i = 0; i < 4; ++i) ss += (cur[i][0] * cur[i][0] + cur[i][1] * cur[i][1]) + (cur[i][2] * cur[i][2] + cur[i][3] * cur[i][3]);
            ss = red64(ss);
            bf16_t* dstp = row < NTOK ? xb + (size_t)row * D : memb + (size_t)(row - NTOK) * D;
#pragma unroll
            for (int i = 0; i < 4; ++i) { u32x2 w2; w2.x = cvt_pk_bf16(cur[i][0], cur[i][1]); w2.y = cvt_pk_bf16(cur[i][2], cur[i][3]); ((u32x2*)dstp)[i * 64 + lane] = w2; }
            if (lane == 0) { if (row < NTOK) rs0[row] = rsqrtf(ss * (1.0f / 1024.0f) + 1e-6f); else rsm[row - NTOK] = rsqrtf(ss * (1.0f / 1024.0f) + 1e-6f); }
#pragma unroll
            for (int i = 0; i < 4; ++i) cur[i] = nxt[i];
        }
#undef RC_SRC
    }
    LAS float* tile = (LAS float*)lds;
#pragma unroll 1
    for (int job = 0; job < 9; ++job) {
        const float* src; const float* gain = nullptr; int ldn = 1024, K = 1024, N = 1024, mode = 0, noff = 0; size_t doff;
        switch (job) {
            case 0: src = p.in[10]; gain = p.in[9]; ldn = 3840; N = 3840; doff = WS_WIN; break;
            case 1: src = p.in[23]; doff = WS_WOUT; break;
            case 2: src = p.in[26]; gain = p.in[24]; doff = WS_WCQ; break;
            case 3: src = p.in[27]; gain = p.in[25]; doff = WS_WKV; break;
            case 4: src = p.in[28]; gain = p.in[25]; doff = WS_WKV; noff = 1024; break;
            case 5: src = p.in[29]; doff = WS_WCO; break;
            case 6: src = p.in[31]; gain = p.in[30]; ldn = 2816; N = 2816; mode = 1; doff = WS_WFF13; break;
            case 7: src = p.in[32]; gain = p.in[30]; ldn = 2816; N = 2816; mode = 2; doff = WS_WFF13; break;
            default: src = p.in[33]; K = 2816; doff = WS_WFF2; break;
        }
        transpose_job(tile, src, ldn, K, N, gain, (bf16_t*)(ws + doff), mode, noff, 1, 0, 0);
    }
    bf16_t* wl = (bf16_t*)(ws + WS_WLORA);
    for (int it = blockIdx.x * 512 + tid; it < 1536 * 32; it += gridDim.x * 512) {
        const int n = it % 1536, k0 = (it / 1536) * 8; const float* src = nullptr; int kb = 0, nn = n;
        if (n < 512) { if (k0 < 64) { src = p.in[14]; kb = k0; } }
        else if (n < 1024) { nn = n - 512; if (k0 >= 64 && k0 < 128) { src = p.in[16]; kb = k0 - 64; } }
        else { nn = n - 1024; if (k0 >= 128) { src = p.in[17]; kb = k0 - 128; } }
        float v[8];
#pragma unroll
        for (int j = 0; j < 8; ++j) v[j] = 0.f;
        if (src) {
#pragma unroll
            for (int j = 0; j < 8; ++j) v[j] = src[(kb + j) * 512 + nn];
        }
        *(u32x4*)(wl + (size_t)n * 256 + k0) = pack8(v);
    }
}

__device__ __forceinline__ void ph_rwprep(const Params& p) {
    const int tid = opaque_tid(), lane = tid & 63, wid = tid >> 6; const int gw = blockIdx.x * 8 + wid, nw = gridDim.x * 8;
    unsigned char* ws = p.ws;
    const bf16_t* prw = (const bf16_t*)(ws + WS_PRW);
    bf16_t* rb = (bf16_t*)(ws + WS_A); bf16_t* vb = (bf16_t*)(ws + WS_A + HALF512);
    bf16_t* al = (bf16_t*)(ws + WS_B); bf16_t* xk = (bf16_t*)(ws + WS_B + 17039360);
    float* kkn = (float*)(ws + WS_KKN);
    const float* mu = p.in[12]; const float* k_k = p.in[18];
    float mu8[3][8], mul[4], kk8[8];
#pragma unroll
    for (int i = 0; i < 3; ++i)
#pragma unroll
        for (int j = 0; j < 8; ++j) mu8[i][j] = mu[i * 512 + lane * 8 + j];
#pragma unroll
    for (int j = 0; j < 4; ++j) mul[j] = mu[1536 + lane * 4 + j];
#pragma unroll
    for (int j = 0; j < 8; ++j) kk8[j] = k_k[lane * 8 + j];
#pragma unroll 1
    for (int row = gw; row < NTOK; row += nw) {
        const float* sh = nullptr; bool first;
        if (row < NTOKP) first = (row & 4095) == 0; else { const int rr = row - NTOKP; first = (rr & 31) == 0; sh = p.in[7] + (size_t)(rr >> 5) * RWC; }
        const bf16_t* cur = prw + (size_t)row * RWC; const bf16_t* prv = first ? cur : cur - RWC;
        u32x4 cw[3], pw[3];
#pragma unroll
        for (int i = 0; i < 3; ++i) { cw[i] = *(const u32x4*)(cur + i * 512 + lane * 8); pw[i] = *(const u32x4*)(prv + i * 512 + lane * 8); }
        const u32x2 cl = *(const u32x2*)(cur + 1536 + lane * 4), pl = *(const u32x2*)(prv + 1536 + lane * 4);
        float pvf[3][8], plf[4];
#pragma unroll
        for (int i = 0; i < 3; ++i) unpack8(pw[i], pvf[i]);
        plf[0] = bf_lo(pl.x); plf[1] = bf_hi(pl.x); plf[2] = bf_lo(pl.y); plf[3] = bf_hi(pl.y);
        if (first) {
            if (sh) {
#pragma unroll
                for (int i = 0; i < 3; ++i) { const f32x4 a = *(const f32x4*)(sh + i * 512 + lane * 8), b2 = *(const f32x4*)(sh + i * 512 + lane * 8 + 4);
                    pvf[i][0] = a[0]; pvf[i][1] = a[1]; pvf[i][2] = a[2]; pvf[i][3] = a[3]; pvf[i][4] = b2[0]; pvf[i][5] = b2[1]; pvf[i][6] = b2[2]; pvf[i][7] = b2[3]; }
                const f32x4 a = *(const f32x4*)(sh + 1536 + lane * 4); plf[0] = a[0]; plf[1] = a[1]; plf[2] = a[2]; plf[3] = a[3];
            } else {
#pragma unroll
                for (int i = 0; i < 3; ++i)
#pragma unroll
                    for (int j = 0; j < 8; ++j) pvf[i][j] = 0.f;
                plf[0] = plf[1] = plf[2] = plf[3] = 0.f;
            }
        }
        const size_t o = (size_t)row * 512 + lane * 8;
#pragma unroll
        for (int i = 0; i < 3; ++i) {
            float c[8], x[8]; unpack8(cw[i], c);
#pragma unroll
            for (int j = 0; j < 8; ++j) x[j] = c[j] + (pvf[i][j] - c[j]) * mu8[i][j];
            if (i == 0) *(u32x4*)(rb + o) = pack8(x);
            else if (i == 2) *(u32x4*)(vb + o) = pack8(x);
            else {
                *(u32x4*)(xk + o) = pack8(x); float ss = 0.f;
#pragma unroll
                for (int j = 0; j < 8; ++j) { const float kv = x[j] * kk8[j]; ss += kv * kv; }
                ss = red8(ss);
                if ((lane & 7) == 0) kkn[row * 8 + (lane >> 3)] = 1.0f / fmaxf(sqrtf(ss), 1e-12f);
            }
        }
        {
            const float c[4] = {bf_lo(cl.x), bf_hi(cl.x), bf_lo(cl.y), bf_hi(cl.y)}; float x[4];
#pragma unroll
            for (int j = 0; j < 4; ++j) { float t = c[j] + (plf[j] - c[j]) * mul[j]; if (lane < 16) t = 1.0f - 2.0f * __builtin_amdgcn_rcpf(__expf(2.0f * t) + 1.0f); else if (lane >= 32) t = sigmoidf_(t); x[j] = t; }
            u32x2 w; w.x = cvt_pk_bf16(x[0], x[1]); w.y = cvt_pk_bf16(x[2], x[3]); *(u32x2*)(al + (size_t)row * 256 + lane * 4) = w;
        }
    }
}
__device__ __forceinline__ void ph_kvconv(const Params& p, LAS unsigned char* lds) {
    const int tid = opaque_tid(); unsigned char* ws = p.ws; bf16_t* kb = (bf16_t*)(ws + WS_KB); bf16_t* vt = (bf16_t*)(ws + WS_VT);
    const size_t per = 256 * 1024;
    {
        const size_t nvec = 24 * per / 4, stride = (size_t)gridDim.x * 512;
        for (size_t i0 = (size_t)blockIdx.x * 512 + tid; i0 < nvec; i0 += 4 * stride) {
            f32x4 v[4];
#pragma unroll
            for (int j = 0; j < 4; ++j) { const size_t i = i0 + j * stride; if (i < nvec) { const size_t e = i * 4; const int b = (int)(e / per); const size_t off = e % per;
                const float* src = b < 8 ? p.out + O_PMK + (size_t)b * per + off : p.in[3] + (size_t)(b - 8) * per + off; v[j] = *(const f32x4*)src; } }
#pragma unroll
            for (int j = 0; j < 4; ++j) { const size_t i = i0 + j * stride; if (i < nvec) { u32x2 w; w.x = cvt_pk_bf16(v[j][0], v[j][1]); w.y = cvt_pk_bf16(v[j][2], v[j][3]); *(u32x2*)(kb + i * 4) = w; } }
        }
    }
    LAS float* tile = (LAS float*)lds;
#pragma unroll 1
    for (int job = 0; job < 2; ++job) {
        const float* src = job ? p.in[4] : p.out + O_PMV; bf16_t* dst = job ? vt + 8 * per : vt; const int nb = job ? 16 : 8;
        transpose_job(tile, src, 1024, 256, 1024, nullptr, dst, 0, 0, nb, per, per);
    }
}

struct RwStep { f32x4 d, k, a, p, r; float v; };
__device__ __forceinline__ void rwkv_scan(const Params& p, LAS unsigned char* lds, int rowbase, int T, int h, int q4, const float* S0, float* Sout) {
    const int tid = opaque_tid(), lane = tid & 63, w = __builtin_amdgcn_readfirstlane(tid >> 6), rowl = lane >> 4, seg = lane & 15; const int vloc = (w & 3) * 4 + rowl, vrow = q4 * 16 + vloc;
    unsigned char* ws = p.ws;
    const float* decay = p.out; const bf16_t* kk = (const bf16_t*)((const unsigned char*)p.out + 68157440); const bf16_t* kka = (const bf16_t*)((const unsigned char*)p.out + 68157440 + HALF512);
    const bf16_t* kp = (const bf16_t*)(ws + WS_PRW); const bf16_t* rb = (const bf16_t*)(ws + WS_A); const bf16_t* vb = (const bf16_t*)(ws + WS_A + HALF512);
    bf16_t* ob = (bf16_t*)(ws + WS_B);
    const bool comp = w < 4;
    f32x4 S = (f32x4){0.f, 0.f, 0.f, 0.f};
    if (comp && S0) S = *(const f32x4*)(S0 + vrow * 64 + seg * 4);
    constexpr int BUF = 43008;
    const bool ldr = w >= 4; const int lt = tid & 255, lstep = lt >> 4, lj = lt & 15;
    f32x4 gd[2]; u32x2 gk[2], ga[2], gp[2], gr[2], gv[2];
    auto gload = [&](int c) {
        if (ldr) {
#pragma unroll
            for (int q = 0; q < 2; ++q) {
                const size_t row = (size_t)(rowbase + c * 32 + lstep + q * 16); const size_t o = row * 512 + h * 64 + lj * 4;
                gd[q] = *(const f32x4*)(decay + o); gk[q] = *(const u32x2*)(kk + o); ga[q] = *(const u32x2*)(kka + o); gp[q] = *(const u32x2*)(kp + o); gr[q] = *(const u32x2*)(rb + o);
                gv[q] = *(const u32x2*)(vb + row * 512 + h * 64 + q4 * 16 + (lj & 3) * 4);
            }
        }
    };
    auto up4 = [](const u32x2 x) { return (f32x4){bf_lo(x.x), bf_hi(x.x), bf_lo(x.y), bf_hi(x.y)}; };
    float selv[16];
#pragma unroll
    for (int i = 0; i < 16; ++i) selv[i] = (seg == i) ? 1.0f : 0.0f;
    const int nch = T / 32;
    gload(0);
#pragma unroll 1
    for (int c = 0; c < nch; ++c) {
        LAS unsigned char* b = lds + (c & 1) * BUF;
        if (ldr) {
#pragma unroll
            for (int q = 0; q < 2; ++q) {
                const int st_ = lstep + q * 16;
                *(LAS f32x4*)(b + st_ * 256 + lj * 16) = gd[q];
                *(LAS f32x4*)(b + 8192 + st_ * 256 + lj * 16) = up4(gk[q]);
                *(LAS f32x4*)(b + 16384 + st_ * 256 + lj * 16) = up4(ga[q]);
                *(LAS f32x4*)(b + 24576 + st_ * 256 + lj * 16) = up4(gp[q]);
                *(LAS f32x4*)(b + 32768 + st_ * 256 + lj * 16) = up4(gr[q]);
                if (lj < 4) *(LAS f32x4*)(b + 40960 + st_ * 64 + lj * 16) = up4(gv[q]);
            }
        }
        __syncthreads();
        if (c + 1 < nch) gload(c + 1);
        if (ldr && c > 0) {
            const int t = lt >> 3, jp = lt & 7; const f32x2 y2 = *(const LAS f32x2*)(lds + 2 * BUF + ((c - 1) & 1) * 2048 + t * 64 + jp * 8);
            *(unsigned*)(ob + (size_t)(rowbase + (c - 1) * 32 + t) * D + 512 + h * 64 + q4 * 16 + jp * 2) = cvt_pk_bf16(y2[0], y2[1]);
        }
        if (comp) {
            const LAS unsigned char* bs = b + seg * 16; const LAS unsigned char* bv = b + 40960 + vloc * 4;
#define RW_LD(X, s) do { X.d = *(const LAS f32x4*)(bs + (s) * 256); X.k = *(const LAS f32x4*)(bs + 8192 + (s) * 256); X.a = *(const LAS f32x4*)(bs + 16384 + (s) * 256); \
                         X.p = *(const LAS f32x4*)(bs + 24576 + (s) * 256); X.r = *(const LAS f32x4*)(bs + 32768 + (s) * 256); X.v = *(const LAS float*)(bv + (s) * 64); } while (0)
#define RW_STEP(X, s) do { float sa = fmaf(S[3], X.k[3], fmaf(S[2], X.k[2], fmaf(S[1], X.k[1], S[0] * X.k[0]))); const f32x4 T = S * X.d + X.v * X.p; sa = -red16(sa); \
                           S = T + sa * X.a; float y = fmaf(S[3], X.r[3], fmaf(S[2], X.r[2], fmaf(S[1], X.r[1], S[0] * X.r[0]))); y = red16(y); \
                           yk = fmaf(selv[(s) & 15], y, yk); } while (0)
            RwStep xa, xb, xc; float yk = 0.f; LAS unsigned char* ybw = lds + 2 * BUF + (c & 1) * 2048 + vloc * 4;
#define RW_YST(s) do { if ((s) == 15) { *(LAS float*)(ybw + seg * 64) = yk; yk = 0.f; } } while (0)
            RW_LD(xa, 0); RW_LD(xb, 1);
#pragma unroll
            for (int s = 0; s < 30; s += 3) {
                RW_LD(xc, s + 2); RW_STEP(xa, s); RW_YST(s);
                RW_LD(xa, s + 3); RW_STEP(xb, s + 1); RW_YST(s + 1);
                RW_LD(xb, s + 4); RW_STEP(xc, s + 2); RW_YST(s + 2);
            }
            RW_STEP(xa, 30); RW_STEP(xb, 31);
            *(LAS float*)(ybw + (16 + seg) * 64) = yk;
#undef RW_YST
#undef RW_LD
#undef RW_STEP
        }
    }
    if (comp) *(f32x4*)(Sout + vrow * 64 + seg * 4) = S;
    __syncthreads();
    if (ldr) {
        const int t = lt >> 3, jp = lt & 7; const f32x2 y2 = *(const LAS f32x2*)(lds + 2 * BUF + ((nch - 1) & 1) * 2048 + t * 64 + jp * 8);
        *(unsigned*)(ob + (size_t)(rowbase + (nch - 1) * 32 + t) * D + 512 + h * 64 + q4 * 16 + jp * 2) = cvt_pk_bf16(y2[0], y2[1]);
    }
    __syncthreads();
}

__device__ __forceinline__ void hg_prep_chunk(const Params& p, LAS unsigned char* lds, int task) {
    const int tid = opaque_tid(), lane = tid & 63, w = __builtin_amdgcn_readfirstlane(tid >> 6), fr = lane & 15, fq = lane >> 4;
    unsigned char* ws = p.ws; bf16_t* phg = (bf16_t*)(ws + WS_PHG); bf16_t* oi = (bf16_t*)(ws + WS_OI); float* decb = (float*)(ws + WS_DECB);
    constexpr int QG = 0, KG = 17408, VT = 34816, ATT = 53248, SEG = 62464;
    int row0, TC, h;
    if (task < 2048) { const int seq = task >> 6, ch = task & 63; h = seq & 3; row0 = (seq >> 2) * 4096 + ch * 64; TC = 64; }
    else { const int s = task - 2048; h = s & 3; row0 = NTOKP + (s >> 2) * 32; TC = 32; }
    const int c = tid & 127, sg = tid >> 7;
    const float l0 = p.in[8][h * 128 + c], l1 = p.in[8][512 + h * 128 + c]; const float lb = 1.0f / (1.0f + __expf(l1 - l0)), omlb = 1.0f - lb;
    const bool valid = sg * 16 < TC;
    float cp[16], kx[16], qv[16], vv[16]; float run = 1.f;
    {
        const bf16_t* rp = phg + (size_t)(row0 + (valid ? sg * 16 : 0)) * HGC + h * 128 + c; bf16_t rq[16], rf[16], rv[16];
#pragma unroll
        for (int j = 0; j < 16; ++j) { rq[j] = rp[(size_t)j * HGC]; rf[j] = rp[(size_t)j * HGC + 512]; rv[j] = rp[(size_t)j * HGC + 1024]; }
#pragma unroll
        for (int j = 0; j < 16; ++j) {
            const float sgm = sigmoidf_(bf1(rf[j])); const float f = valid ? lb + omlb * sgm : 1.0f; run *= f; cp[j] = run;
            kx[j] = valid ? omlb * (1.0f - sgm) : 0.f; qv[j] = valid ? bf1(rq[j]) : 0.f; vv[j] = valid ? bf1(rv[j]) : 0.f;
        }
    }
    *(LAS float*)(lds + SEG + (sg * 128 + c) * 4) = run;
    __syncthreads();
    float pre = 1.f, tot = 1.f;
#pragma unroll
    for (int s2 = 0; s2 < 4; ++s2) { const float x = *(const LAS float*)(lds + SEG + (s2 * 128 + c) * 4); tot *= x; if (s2 < sg) pre *= x; }
    {
        float kd[16];
#pragma unroll
        for (int j = 0; j < 16; ++j) {
            const float P = pre * cp[j]; const int t = sg * 16 + j; const float qg = qv[j] * P, kg = kx[j] * __builtin_amdgcn_rcpf(P);
            const bf16_t qgb = f2bf(qg);
            *(LAS bf16_t*)(lds + QG + t * 272 + c * 2) = qgb;
            *(LAS bf16_t*)(lds + KG + t * 272 + c * 2) = f2bf(kg);
            kd[j] = kg * tot;
            if (valid) phg[(size_t)(row0 + t) * HGC + h * 128 + c] = qgb;
        }
        const u32x4 v0 = pack8(vv), v1 = pack8(vv + 8);
        *(LAS u32x4*)(lds + VT + c * 144 + sg * 32) = v0; *(LAS u32x4*)(lds + VT + c * 144 + sg * 32 + 16) = v1;
        if (valid) {
            const int lin = c * TC + sg * 16; bf16_t* dst = phg + (size_t)(row0 + (lin >> 7)) * HGC + h * 128 + (lin & 127);
            *(u32x4*)(dst + 512) = pack8(kd); *(u32x4*)(dst + 512 + 8) = pack8(kd + 8);
            *(u32x4*)(dst + 1024) = v0; *(u32x4*)(dst + 1024 + 8) = v1;
        }
        if (sg == 0) decb[task * 128 + c] = tot;
    }
    __syncthreads();
    {
        const int tt = w >> 1;
#pragma unroll
        for (int q2 = 0; q2 < 2; ++q2) {
            const int st = 2 * (w & 1) + q2; f32x4 a = {0.f, 0.f, 0.f, 0.f};
#pragma unroll
            for (int ks = 0; ks < 4; ++ks) {
                const bf16x8 kf = *(const LAS bf16x8*)(lds + KG + (st * 16 + fr) * 272 + (ks * 32 + fq * 8) * 2);
                const bf16x8 qf = *(const LAS bf16x8*)(lds + QG + (tt * 16 + fr) * 272 + (ks * 32 + fq * 8) * 2);
                a = __builtin_amdgcn_mfma_f32_16x16x32_bf16(kf, qf, a, 0, 0, 0);
            }
            const int t = tt * 16 + fr; float m[4];
#pragma unroll
            for (int j = 0; j < 4; ++j) { const int s = st * 16 + fq * 4 + j; m[j] = (s <= t) ? a[j] : 0.f; }
            u32x2 wv; wv.x = cvt_pk_bf16(m[0], m[1]); wv.y = cvt_pk_bf16(m[2], m[3]);
            *(LAS u32x2*)(lds + ATT + t * 144 + (st * 16 + fq * 4) * 2) = wv;
        }
    }
    __syncthreads();
#pragma unroll
    for (int tt = 0; tt < 4; ++tt) {
        f32x4 a = {0.f, 0.f, 0.f, 0.f};
#pragma unroll
        for (int ks = 0; ks < 2; ++ks) {
            const bf16x8 vf = *(const LAS bf16x8*)(lds + VT + (w * 16 + fr) * 144 + (ks * 32 + fq * 8) * 2);
            const bf16x8 af = *(const LAS bf16x8*)(lds + ATT + (tt * 16 + fr) * 144 + (ks * 32 + fq * 8) * 2);
            a = __builtin_amdgcn_mfma_f32_16x16x32_bf16(vf, af, a, 0, 0, 0);
        }
        const int t = tt * 16 + fr;
        if (t < TC) { u32x2 wv; wv.x = cvt_pk_bf16(a[0], a[1]); wv.y = cvt_pk_bf16(a[2], a[3]); *(u32x2*)(oi + ((size_t)(h * 4 + (w >> 1)) * NTOK + row0 + t) * 32 + (w & 1) * 16 + fq * 4) = wv; }
    }
    __syncthreads();
}
__device__ __forceinline__ void ph_hgprep(const Params& p, LAS unsigned char* lds) {
#pragma unroll 1
    for (int t = blockIdx.x; t < 2112; t += gridDim.x) hg_prep_chunk(p, lds, t);
}
__device__ __forceinline__ void hg_seq(const Params& p, LAS unsigned char* lds, int task) {
    const int tid = opaque_tid(), lane = tid & 63, w = __builtin_amdgcn_readfirstlane(tid >> 6), fr = lane & 15, fq = lane >> 4;
    unsigned char* ws = p.ws; const bf16_t* phg = (const bf16_t*)(ws + WS_PHG); const bf16_t* oi = (const bf16_t*)(ws + WS_OI); const float* decb = (const float*)(ws + WS_DECB); bf16_t* ob = (bf16_t*)(ws + WS_B);
    constexpr int QG = 0, KDT = 17408, VT = 35840, ST = 40448;
    int rowbase, TC, h, vq, nch, dbase; const float* S0 = nullptr; float* Sout;
    if (task < 128) { const int b = task >> 4; h = (task >> 2) & 3; vq = task & 3; rowbase = b * 4096; TC = 64; nch = 64; dbase = (b * 4 + h) * 64; Sout = p.out + O_PHG + (size_t)(b * 4 + h) * 16384; }
    else { const int s = task - 128, b = s >> 4; h = (s >> 2) & 3; vq = s & 3; rowbase = NTOKP + b * 32; TC = 32; nch = 1; dbase = 2048 + b * 4 + h; S0 = p.in[5] + (size_t)(b * 4 + h) * 16384; Sout = p.out + O_SHG + (size_t)(b * 4 + h) * 16384; }
    f32x4 S[2];
#pragma unroll
    for (int vt = 0; vt < 2; ++vt)
#pragma unroll
        for (int j = 0; j < 4; ++j) S[vt][j] = S0 ? S0[(w * 16 + fq * 4 + j) * 128 + vq * 32 + vt * 16 + fr] : 0.f;
    const int tt = w >> 1, vt_o = w & 1;
    const int prow = tid >> 4, pcol = tid & 15;
    struct HgR { u32x4 gq[2], gk[2], gv; u32x2 go; f32x4 gdec; };
    auto gload = [&](HgR& R, int ch) {
        const int row0 = rowbase + ch * 64;
#pragma unroll
        for (int j = 0; j < 2; ++j) {
            const int r = prow + j * 32; const bool ok = r < TC;
            const bf16_t* src = phg + (size_t)(row0 + (ok ? r : 0)) * HGC + h * 128 + pcol * 8;
            R.gq[j] = *(const u32x4*)src; R.gk[j] = *(const u32x4*)(src + 512);
        }
        if (tid < 256) {
            const int r = tid >> 4; const bool ok = r < (TC >> 2);
            const bf16_t* src = phg + (size_t)(row0 + ((vq * 32 * TC) >> 7) + (ok ? r : 0)) * HGC + 1024 + h * 128 + pcol * 8;
            R.gv = *(const u32x4*)src;
        }
        { const int t = tt * 16 + fr; const bool ok = t < TC; R.go = *(const u32x2*)(oi + ((size_t)(h * 4 + vq) * NTOK + row0 + (ok ? t : 0)) * 32 + vt_o * 16 + fq * 4); }
        R.gdec = *(const f32x4*)(decb + (size_t)(dbase + ch) * 128 + w * 16 + fq * 4);
    };
    HgR ra, rb;
    gload(ra, 0); if (nch > 1) gload(rb, 1);
    auto body = [&](HgR& R, int ch) {
        const int row0 = rowbase + ch * 64;
#pragma unroll
        for (int j = 0; j < 2; ++j) {
            const int r = prow + j * 32; const u32x4 z4 = (u32x4){0u, 0u, 0u, 0u};
            *(LAS u32x4*)(lds + QG + r * 272 + pcol * 16) = (r < TC) ? R.gq[j] : z4;
            if (TC == 64) { const int lin = r * 128 + pcol * 8; *(LAS u32x4*)(lds + KDT + (lin >> 6) * 144 + (lin & 63) * 2) = R.gk[j]; }
            else if (r < 32) { const int lin = r * 128 + pcol * 8; *(LAS u32x4*)(lds + KDT + (lin >> 5) * 144 + (lin & 31) * 2) = R.gk[j]; }
        }
        if (TC == 32 && tid < 256) {
#pragma unroll
            for (int j = 0; j < 2; ++j) { const int i2 = tid + j * 256; *(LAS u32x4*)(lds + KDT + (i2 >> 2) * 144 + 64 + (i2 & 3) * 16) = (u32x4){0u, 0u, 0u, 0u}; }
        }
        if (tid < 256) {
            const int r = tid >> 4; const int lin = r * 128 + pcol * 8;
            if (TC == 64) *(LAS u32x4*)(lds + VT + (lin >> 6) * 144 + (lin & 63) * 2) = R.gv;
            else { if (r < 8) *(LAS u32x4*)(lds + VT + (lin >> 5) * 144 + (lin & 31) * 2) = R.gv;
                   *(LAS u32x4*)(lds + VT + (tid >> 3) * 144 + 64 + (tid & 3) * 16 + ((tid >> 2) & 1) * 0) = (u32x4){0u, 0u, 0u, 0u}; }
        }
#pragma unroll
        for (int vt = 0; vt < 2; ++vt) { u32x2 wv; wv.x = cvt_pk_bf16(S[vt][0], S[vt][1]); wv.y = cvt_pk_bf16(S[vt][2], S[vt][3]); *(LAS u32x2*)(lds + ST + (vt * 16 + fr) * 272 + (w * 16 + fq * 4) * 2) = wv; }
        const float oi0 = bf_lo(R.go.x), oi1 = bf_hi(R.go.x), oi2 = bf_lo(R.go.y), oi3 = bf_hi(R.go.y);
        S[0] = S[0] * R.gdec; S[1] = S[1] * R.gdec;
        __syncthreads();
        if (ch + 2 < nch) gload(R, ch + 2);
        {
            f32x4 a = {0.f, 0.f, 0.f, 0.f};
#pragma unroll
            for (int ks = 0; ks < 4; ++ks) {
                const bf16x8 sf = *(const LAS bf16x8*)(lds + ST + (vt_o * 16 + fr) * 272 + (ks * 32 + fq * 8) * 2);
                const bf16x8 qf = *(const LAS bf16x8*)(lds + QG + (tt * 16 + fr) * 272 + (ks * 32 + fq * 8) * 2);
                a = __builtin_amdgcn_mfma_f32_16x16x32_bf16(sf, qf, a, 0, 0, 0);
            }
            const int t = tt * 16 + fr;
            if (t < TC) {
                u32x2 wv; wv.x = cvt_pk_bf16(a[0] + oi0, a[1] + oi1); wv.y = cvt_pk_bf16(a[2] + oi2, a[3] + oi3);
                *(u32x2*)((bf16_t*)oi + ((size_t)(h * 4 + vq) * NTOK + row0 + t) * 32 + vt_o * 16 + fq * 4) = wv;
            }
        }
#pragma unroll
        for (int vt = 0; vt < 2; ++vt) {
#pragma unroll
            for (int ks = 0; ks < 2; ++ks) {
                const bf16x8 kf = *(const LAS bf16x8*)(lds + KDT + (w * 16 + fr) * 144 + (ks * 32 + fq * 8) * 2);
                const bf16x8 vf = *(const LAS bf16x8*)(lds + VT + (vt * 16 + fr) * 144 + (ks * 32 + fq * 8) * 2);
                S[vt] = __builtin_amdgcn_mfma_f32_16x16x32_bf16(kf, vf, S[vt], 0, 0, 0);
            }
        }
        __syncthreads();
    };
#pragma unroll 1
    for (int ch = 0; ch < nch; ch += 2) { body(ra, ch); if (ch + 1 < nch) body(rb, ch + 1); }
#pragma unroll
    for (int vt = 0; vt < 2; ++vt)
#pragma unroll
        for (int j = 0; j < 4; ++j) Sout[(w * 16 + fq * 4 + j) * 128 + vq * 32 + vt * 16 + fr] = S[vt][j];
}
__device__ __forceinline__ void ph_hgseq(const Params& p, LAS unsigned char* lds, int first, int nblk) {
#pragma unroll 1
    for (int t = (int)blockIdx.x - first; t < 384; t += nblk) hg_seq(p, lds, t);
}
__device__ __forceinline__ void ph_scan(const Params& p, LAS unsigned char* lds) {
#pragma unroll 1
    for (int task = blockIdx.x; task < 768; task += gridDim.x) {
        if (task < 256) { const int b = task >> 5, h = (task >> 2) & 7, q4 = task & 3; rwkv_scan(p, lds, b * 4096, 4096, h, q4, nullptr, p.out + O_PRW + (size_t)(b * 8 + h) * 4096); }
        else { const int t = task - 256, b = t >> 5, h = (t >> 2) & 7, q4 = t & 3; rwkv_scan(p, lds, NTOKP + b * 32, 32, h, q4, p.in[6] + (size_t)(b * 8 + h) * 4096, p.out + O_SRW + (size_t)(b * 8 + h) * 4096); }
    }
}

__device__ __forceinline__ void ph_rwpost(const Params& p) {
    const int tid = opaque_tid(), lane = tid & 63, wid = tid >> 6; const int gw = blockIdx.x * 8 + wid, nw = gridDim.x * 8;
    unsigned char* ws = p.ws; bf16_t* ob = (bf16_t*)(ws + WS_B); const bf16_t* phg = (const bf16_t*)(ws + WS_PHG); const bf16_t* oi = (const bf16_t*)(ws + WS_OI);
    const bf16_t* kp = (const bf16_t*)(ws + WS_PRW); const bf16_t* gb = (const bf16_t*)(ws + WS_PRW + HALF512); const bf16_t* rb = (const bf16_t*)(ws + WS_A); const bf16_t* vb = (const bf16_t*)(ws + WS_A + HALF512);
    const int c = lane * 8; float rk[8], gw8[8], gb8[8], hn[8];
#pragma unroll
    for (int j = 0; j < 8; ++j) { rk[j] = p.in[20][c + j]; gw8[j] = p.in[21][c + j]; gb8[j] = p.in[22][c + j]; hn[j] = p.in[11][c + j]; }
    u32x4 cur[7], nxt[7];
#define RP_LD(X, row) do { const size_t o_ = (size_t)(row) * 512 + c; X[0] = *(const u32x4*)(ob + (size_t)(row) * D + 512 + c); X[1] = *(const u32x4*)(rb + o_); X[2] = *(const u32x4*)(kp + o_); \
        X[3] = *(const u32x4*)(vb + o_); X[4] = *(const u32x4*)(gb + o_); X[5] = *(const u32x4*)(oi + ((size_t)(c >> 5) * NTOK + (row)) * 32 + (c & 31)); X[6] = *(const u32x4*)(phg + (size_t)(row) * HGC + 1536 + c); } while (0)
    int row = gw;
    if (row < NTOK) RP_LD(cur, row);
#pragma unroll 1
    for (; row < NTOK; row += nw) {
        const int nr = row + nw;
        if (nr < NTOK) RP_LD(nxt, nr);
        float y[8], r[8], k[8], v[8], g[8], ho[8], hg[8];
        unpack8(cur[0], y); unpack8(cur[1], r); unpack8(cur[2], k); unpack8(cur[3], v); unpack8(cur[4], g); unpack8(cur[5], ho); unpack8(cur[6], hg);
        float s = 0.f, bs = 0.f, hs = 0.f;
#pragma unroll
        for (int j = 0; j < 8; ++j) { s += y[j]; bs += r[j] * k[j] * rk[j]; hs += ho[j] * ho[j]; }
        s = red8(s); bs = red8(bs); hs = red16(hs); const float mean = s * (1.0f / 64.0f); float q = 0.f;
#pragma unroll
        for (int j = 0; j < 8; ++j) { const float d = y[j] - mean; q += d * d; }
        q = red8(q); const float rstd = rsqrtf(q * (1.0f / 64.0f) + 64e-5f); const float hrs = rsqrtf(hs * (1.0f / 128.0f) + 1e-6f); float out[8], hout[8];
#pragma unroll
        for (int j = 0; j < 8; ++j) { out[j] = ((y[j] - mean) * rstd * gw8[j] + gb8[j] + bs * v[j]) * g[j]; hout[j] = ho[j] * hrs * hn[j] * (hg[j] * sigmoidf_(hg[j])); }
        *(u32x4*)(ob + (size_t)row * D + 512 + c) = pack8(out);
        *(u32x4*)(ob + (size_t)row * D + c) = pack8(hout);
#pragma unroll
        for (int i = 0; i < 7; ++i) cur[i] = nxt[i];
    }
#undef RP_LD
}

__device__ __forceinline__ void ph_attn(const Params& p, LAS unsigned char* lds) {
    const int tid = opaque_tid(), lane = tid & 63, w = __builtin_amdgcn_readfirstlane(tid >> 6), fr = lane & 15, fq = lane >> 4;
    unsigned char* ws = p.ws; const bf16_t* qb = (const bf16_t*)(ws + WS_A); const bf16_t* kb = (const bf16_t*)(ws + WS_KB); const bf16_t* vt = (const bf16_t*)(ws + WS_VT); bf16_t* ao = (bf16_t*)(ws + WS_B);
    constexpr int PR = 36864;
    LAS unsigned char* pw = lds + PR + w * 8448 + fr * 528 + fq * 8;
    const unsigned koff = (unsigned)((tid >> 5) * 1024 + (tid & 31) * 8);
    const unsigned voff = (unsigned)((tid >> 3) * 256 + (tid & 7) * 8);
    LAS unsigned char* kst = lds + (tid >> 5) * 528 + (tid & 31) * 16;
    LAS unsigned char* vst = lds + (tid >> 3) * 144 + (tid & 7) * 16;
    const LAS unsigned char* krd = lds + fr * 528 + fq * 16;
    const LAS unsigned char* vrd = lds + fr * 144 + fq * 16;
#pragma unroll 1
    for (int u = blockIdx.x; u < 1088; u += gridDim.x) {
        int r0, nrows, kvb, h;
        if (u < 1024) { const int tile = u >> 2; h = u & 3; r0 = tile * 128; nrows = 128; kvb = tile >> 5; }
        else { const int s = u - 1024, b = s >> 2; h = s & 3; r0 = NTOKP + b * 32; nrows = 32; kvb = 8 + b; }
        const bool active = (w * 16) < nrows;
        bf16x8 qf[8];
        if (active) {
            const bf16_t* qp = qb + (size_t)(r0 + w * 16 + fr) * D + h * 256 + fq * 8;
#pragma unroll
            for (int ks = 0; ks < 8; ++ks) qf[ks] = *(const bf16x8*)(qp + ks * 32);
        }
        u32x4 st[4];
        const bf16_t* kbase = kb + (size_t)kvb * 256 * 1024 + h * 256; const bf16_t* vbase = vt + ((size_t)kvb * 1024 + h * 256) * 256;
#define LOADK(i) do { _Pragma("unroll") for (int j = 0; j < 4; ++j) st[j] = *(const u32x4*)(kbase + ((i) * 64 + j * 16) * 1024 + koff); } while (0)
#define LOADV(i) do { _Pragma("unroll") for (int j = 0; j < 4; ++j) st[j] = *(const u32x4*)(vbase + (j * 64 * 256 + (i) * 64) + voff); } while (0)
#define STOREK() do { _Pragma("unroll") for (int j = 0; j < 4; ++j) *(LAS u32x4*)(kst + j * 16 * 528) = st[j]; } while (0)
#define STOREV() do { _Pragma("unroll") for (int j = 0; j < 4; ++j) *(LAS u32x4*)(vst + j * 64 * 144) = st[j]; } while (0)
        f32x4 sc[16];
        LOADK(0);
#pragma unroll
        for (int i = 0; i < 4; ++i) {
            __syncthreads(); STOREK(); __syncthreads();
            if (i < 3) LOADK(i + 1); else LOADV(0);
            if (active) {
#pragma unroll
                for (int sub = 0; sub < 4; ++sub) {
                    f32x4 a = {0.f, 0.f, 0.f, 0.f};
#pragma unroll
                    for (int ks = 0; ks < 8; ++ks) {
                        const bf16x8 kf = *(const LAS bf16x8*)(krd + sub * 16 * 528 + ks * 64);
                        a = __builtin_amdgcn_mfma_f32_16x16x32_bf16(kf, qf[ks], a, 0, 0, 0);
                    }
                    sc[i * 4 + sub] = a;
                }
            }
        }
        float linv = 0.f;
        if (active) {
            float mx = -3.0e38f;
#pragma unroll
            for (int t = 0; t < 16; ++t)
#pragma unroll
                for (int j = 0; j < 4; ++j) mx = fmaxf(mx, sc[t][j]);
            mx = fmaxf(mx, __shfl_xor(mx, 16)); mx = fmaxf(mx, __shfl_xor(mx, 32));
            float l = 0.f;
#pragma unroll
            for (int t = 0; t < 16; ++t) {
                float e[4];
#pragma unroll
                for (int j = 0; j < 4; ++j) { e[j] = __expf(sc[t][j] - mx); l += e[j]; }
                u32x2 wv; wv.x = cvt_pk_bf16(e[0], e[1]); wv.y = cvt_pk_bf16(e[2], e[3]);
                *(LAS u32x2*)(pw + t * 32) = wv;
            }
            l += __shfl_xor(l, 16); l += __shfl_xor(l, 32); linv = 1.0f / l;
        }
        f32x4 oa[16];
#pragma unroll
        for (int dt = 0; dt < 16; ++dt) oa[dt] = (f32x4){0.f, 0.f, 0.f, 0.f};
#pragma unroll 1
        for (int i = 0; i < 4; ++i) {
            __syncthreads(); STOREV(); __syncthreads();
            if (i < 3) LOADV(i + 1);
            if (active) {
#pragma unroll
                for (int ks = 0; ks < 2; ++ks) {
                    const bf16x8 pf = *(const LAS bf16x8*)(pw + fq * 8 + i * 128 + ks * 64);
#pragma unroll
                    for (int dt = 0; dt < 16; ++dt) {
                        const bf16x8 vf = *(const LAS bf16x8*)(vrd + dt * 16 * 144 + ks * 64);
                        oa[dt] = __builtin_amdgcn_mfma_f32_16x16x32_bf16(vf, pf, oa[dt], 0, 0, 0);
                    }
                }
            }
        }
        if (active) {
            bf16_t* dst = ao + (size_t)(r0 + w * 16 + fr) * D + h * 256 + fq * 4;
#pragma unroll
            for (int dt = 0; dt < 16; ++dt) { u32x2 wv; wv.x = cvt_pk_bf16(oa[dt][0] * linv, oa[dt][1] * linv); wv.y = cvt_pk_bf16(oa[dt][2] * linv, oa[dt][3] * linv); *(u32x2*)(dst + dt * 16) = wv; }
        }
        __syncthreads();
#undef LOADK
#undef LOADV
#undef STOREK
#undef STOREV
    }
}

__device__ __forceinline__ void ph_final(const Params& p) {
    const int tid = opaque_tid(), lane = tid & 63, wid = tid >> 6; const int gw = blockIdx.x * 8 + wid, nw = gridDim.x * 8;
    f32x4 gn[4], cur[4], nxt[4];
#pragma unroll
    for (int i = 0; i < 4; ++i) gn[i] = ((const f32x4*)p.in[34])[i * 64 + lane];
    int row = gw;
    if (row < NTOK) { const f32x4* x = (const f32x4*)(p.out + (size_t)row * D);
#pragma unroll
        for (int i = 0; i < 4; ++i) cur[i] = x[i * 64 + lane]; }
#pragma unroll 1
    for (; row < NTOK; row += nw) {
        const int nr = row + nw;
        if (nr < NTOK) { const f32x4* x = (const f32x4*)(p.out + (size_t)nr * D);
#pragma unroll
            for (int i = 0; i < 4; ++i) nxt[i] = x[i * 64 + lane]; }
        float ss = 0.f;
#pragma unroll
        for (int i = 0; i < 4; ++i) ss += (cur[i][0] * cur[i][0] + cur[i][1] * cur[i][1]) + (cur[i][2] * cur[i][2] + cur[i][3] * cur[i][3]);
        ss = red64(ss); const float rs = rsqrtf(ss * (1.0f / 1024.0f) + 1e-6f);
        f32x4* xo = (f32x4*)(p.out + (size_t)row * D);
#pragma unroll
        for (int i = 0; i < 4; ++i) xo[i * 64 + lane] = cur[i] * rs * gn[i];
#pragma unroll
        for (int i = 0; i < 4; ++i) cur[i] = nxt[i];
    }
}

#define XB_TMO      128
#define XB_XCNT(j)  (256  + 64 * (j))
#define XB_XSUB(j)  (1280 + 64 * (j))
#define XB_XGEN(j)  (2304 + 64 * (j))
#define XB_TOP      3328
#define XB_TOPGEN   3392
#define XCD_BAR_WORDS 3456
#define XB_SPIN_CAP (1u << 18)

__device__ __forceinline__ unsigned xb_ld(unsigned* p)              { return __hip_atomic_load(p, __ATOMIC_RELAXED, __HIP_MEMORY_SCOPE_AGENT); }
__device__ __forceinline__ unsigned xb_add(unsigned* p, unsigned v) { return __hip_atomic_fetch_add(p, v, __ATOMIC_RELAXED, __HIP_MEMORY_SCOPE_AGENT); }
__device__ __forceinline__ unsigned xb_xcc_id() { return (unsigned)__builtin_amdgcn_s_getreg((3 << 11) | 20) & 0xFu; }
#define XB_SPIN(cond, bar) do { unsigned _sp = 0; while (cond) { __builtin_amdgcn_s_sleep(1); \
    if ((++_sp & 255u) == 0u) { if (xb_ld(&(bar)[XB_TMO])) break; if (_sp > XB_SPIN_CAP) { atomicAdd(&(bar)[XB_TMO], 1u); break; } } } } while (0)

struct XcdBarrier {
    unsigned* bar; unsigned x;
    volatile LAS unsigned* st;
};

__device__ __forceinline__ XcdBarrier xcd_barrier_post(unsigned* bar, volatile LAS unsigned* st) {
    XcdBarrier b; b.bar = bar; b.x = xb_xcc_id(); b.st = st;
    if (threadIdx.x == 0) (void)xb_add(&bar[XB_XCNT(b.x)], 1u);
    return b;
}
__device__ __forceinline__ void xcd_barrier_complete(unsigned* bar, unsigned x, unsigned& nloc, unsigned& nx) {
    const unsigned G = gridDim.x * gridDim.y * gridDim.z;
    unsigned sum, cnt, mine, sp = 0u;
    for (;;) {
        sum = 0u; cnt = 0u; mine = 0u;
#pragma unroll
        for (unsigned j = 0; j < 16; ++j) { const unsigned c = xb_ld(&bar[XB_XCNT(j)]); sum += c; cnt += (c > 0u) ? 1u : 0u; mine = (j == x) ? c : mine; }
        if (sum == G) break;
        __builtin_amdgcn_s_sleep(1);
        if ((++sp & 255u) == 0u) { if (xb_ld(&bar[XB_TMO])) break; if (sp > XB_SPIN_CAP) { atomicAdd(&bar[XB_TMO], 1u); break; } }
    }
    nloc = mine > 0u ? mine : 1u; nx = cnt > 0u ? cnt : 1u;
}

__device__ __forceinline__ void xcd_barrier(const XcdBarrier& b) {
    asm volatile("s_waitcnt vmcnt(0)" ::: "memory");
    __syncthreads();
    if (threadIdx.x == 0) {
        unsigned* bar = b.bar;
        __builtin_amdgcn_s_waitcnt(0);
        unsigned nloc = b.st[0], nx = b.st[1];
        if (nloc == 0u) { xcd_barrier_complete(bar, b.x, nloc, nx); b.st[0] = nloc; b.st[1] = nx; }
        const unsigned old = xb_add(&bar[XB_XSUB(b.x)], 1u);
        const unsigned gen = old / nloc;
        if (old + 1u == (gen + 1u) * nloc) {
            __builtin_amdgcn_fence(__ATOMIC_RELEASE, "agent");
            asm volatile("s_waitcnt vmcnt(0)" ::: "memory");
            const unsigned og = xb_add(&bar[XB_TOP], 1u);
            const unsigned tg = og / nx;
            if (og + 1u == (tg + 1u) * nx) xb_add(&bar[XB_TOPGEN], 1u);
            else XB_SPIN(xb_ld(&bar[XB_TOPGEN]) == tg, bar);
            __builtin_amdgcn_fence(__ATOMIC_ACQUIRE, "agent");
            xb_add(&bar[XB_XGEN(b.x)], 1u);
            asm volatile("s_waitcnt vmcnt(0)" ::: "memory");
        } else {
            XB_SPIN(xb_ld(&bar[XB_XGEN(b.x)]) == gen, bar);
            __builtin_amdgcn_fence(__ATOMIC_ACQUIRE, "agent");
            asm volatile("s_waitcnt vmcnt(0)" ::: "memory");
        }
    }
    __syncthreads();
}


__device__ __forceinline__ void grid_sync_cg() {
    asm volatile("s_waitcnt vmcnt(0) lgkmcnt(0)" ::: "memory");
    __syncthreads();
    if (threadIdx.x == 0) { __builtin_amdgcn_fence(__ATOMIC_RELEASE, "agent"); asm volatile("s_waitcnt vmcnt(0)" ::: "memory"); }
    cg::this_grid().sync();
    if (threadIdx.x < 64) { __builtin_amdgcn_fence(__ATOMIC_ACQUIRE, "agent"); asm volatile("s_waitcnt vmcnt(0)" ::: "memory"); }
    __syncthreads();
}
__device__ __forceinline__ void grid_sync_fast(unsigned* bar, unsigned& epoch) {
    asm volatile("s_waitcnt vmcnt(0) lgkmcnt(0)" ::: "memory");
    __syncthreads();
    epoch += 1;
    if (threadIdx.x == 0) {
        __builtin_amdgcn_fence(__ATOMIC_RELEASE, "agent");
        asm volatile("s_waitcnt vmcnt(0)" ::: "memory");
        __hip_atomic_fetch_add(bar, 1u, __ATOMIC_RELAXED, __HIP_MEMORY_SCOPE_AGENT);
        const unsigned target = epoch * gridDim.x;
        while (__hip_atomic_load(bar, __ATOMIC_RELAXED, __HIP_MEMORY_SCOPE_AGENT) < target) __builtin_amdgcn_s_sleep(2);
        __builtin_amdgcn_fence(__ATOMIC_ACQUIRE, "agent");
        asm volatile("s_waitcnt vmcnt(0)" ::: "memory");
    }
    __syncthreads();
}
__global__ void __launch_bounds__(512, 2) mk_fwd(Params p) {
    extern __shared__ __attribute__((aligned(16))) unsigned char smem[];
    LAS unsigned char* lds = (LAS unsigned char*)smem;
    unsigned char* ws = p.ws; const int G = gridDim.x, bid = blockIdx.x;
    volatile LAS unsigned* st_ = (volatile LAS unsigned*)(lds + 131072);
    if (threadIdx.x == 0) { st_[0] = 0u; st_[1] = 0u; }
    __syncthreads();
    const XcdBarrier xb_ = xcd_barrier_post((unsigned*)(ws + WS_BAR), st_);
#ifndef PHMASK
#define PHMASK 0x1fff
#endif
#define IN(k) (((PHMASK >> (k)) & 1) && p.lo <= (k) && (k) < p.hi)
#ifndef DUPMASK
#define DUPMASK 0
#endif
#define REPS(k) for (int rep_ = 0; rep_ < 1 + ((DUPMASK >> (k)) & 1); ++rep_)
#define RSYNC() do { if (rep_) xcd_barrier(xb_); } while (0)
#define SEAM(k) do { if (IN(k) && IN((k) + 1)) xcd_barrier(xb_); } while (0)
    if (p.lo > 1000) grid_sync_cg();
    if (IN(0)) REPS(0) { RSYNC(); ph_prep(p, lds); }
    SEAM(0);
    if (IN(1)) REPS(1) { RSYNC();
        { pg8::Gemm g{(const bf16_t*)(ws + WS_A), (const bf16_t*)(ws + WS_WIN), NTOK, 3840, 1024}; pg8::StaticOrder S; S.init(NTOK, 3840, G, bid);
          EpiWin E{(bf16_t*)(ws + WS_PHG), (bf16_t*)(ws + WS_PRW), (const float*)(ws + WS_RS0), p.out + O_PSH, p.out + O_SSH}; pg8::gemm_phase(lds, g, S, E); }
        { pg8::Gemm g{(const bf16_t*)(ws + WS_MEMB), (const bf16_t*)(ws + WS_WKV), 2048, 2048, 1024}; pg8::StaticOrder S; S.init(2048, 2048, G, (bid + G - 160 % G) % G);
          EpiMemKV E{p.out + O_PMK, p.out + O_PMV, (const float*)(ws + WS_RSM)}; pg8::gemm_phase(lds, g, S, E); }
    }
    SEAM(1);
    if (IN(2)) { ph_rwprep(p); ph_kvconv(p, lds); ph_hgprep(p, lds); }
    SEAM(2);
    if (IN(3)) {
        const bool split = (G == 256);
        pg8::Gemm g{(const bf16_t*)(ws + WS_B), (const bf16_t*)(ws + WS_WLORA), NTOK, 1536, 256}; pg8::StaticOrder S;
        EpiLora E{p.out, (bf16_t*)((unsigned char*)p.out + 68157440), (bf16_t*)((unsigned char*)p.out + 68157440 + HALF512), (bf16_t*)(ws + WS_PRW), (bf16_t*)(ws + WS_PRW + HALF512),
                  (const bf16_t*)(ws + WS_B + 17039360), (const float*)(ws + WS_KKN), p.in[13], p.in[15], p.in[18], p.in[19]};
        if (!split) { S.init(NTOK, 1536, G, bid); pg8::gemm_phase(lds, g, S, E); __syncthreads(); ph_hgseq(p, lds, 0, G); }
        else {
            if (bid < 128) { S.init(NTOK, 1536, 128, bid); S.window(0, 640); }
            else { ph_hgseq(p, lds, 128, 128); __syncthreads(); S.init(NTOK, 1536, 128, bid - 128); S.window(640, 780); }
            pg8::gemm_phase(lds, g, S, E);
        }
    }
    SEAM(3);
    if (IN(4)) REPS(4) { RSYNC(); ph_scan(p, lds); }
    SEAM(4);
    if (IN(5)) ph_rwpost(p);
    SEAM(5);
    if (IN(6)) {
        sgemm_sample<0>(lds, (const bf16_t*)(ws + WS_B), (const bf16_t*)(ws + WS_WOUT), 1024, p.in[2], p.out, (bf16_t*)(ws + WS_PRW), (float*)(ws + WS_SSQ1), nullptr);
        pg8::Gemm g{(const bf16_t*)(ws + WS_B), (const bf16_t*)(ws + WS_WOUT), NTOKP, 1024, 1024}; pg8::StaticOrder S; S.init(NTOKP, 1024, G, bid);
        EpiRes E{p.in[0], p.in[2], p.out, (bf16_t*)(ws + WS_PRW), (float*)(ws + WS_SSQ1)}; pg8::gemm_phase(lds, g, S, E);
    }
    SEAM(6);
    if (IN(7)) {
        sgemm_sample<1>(lds, (const bf16_t*)(ws + WS_PRW), (const bf16_t*)(ws + WS_WCQ), 1024, nullptr, nullptr, (bf16_t*)(ws + WS_A), nullptr, (const float*)(ws + WS_SSQ1));
        pg8::Gemm g{(const bf16_t*)(ws + WS_PRW), (const bf16_t*)(ws + WS_WCQ), NTOKP, 1024, 1024}; pg8::StaticOrder S; S.init(NTOKP, 1024, G, bid);
        EpiQ E{(bf16_t*)(ws + WS_A), (const float*)(ws + WS_SSQ1)}; pg8::gemm_phase(lds, g, S, E);
    }
    SEAM(7);
    if (IN(8)) REPS(8) { RSYNC(); ph_attn(p, lds); }
    SEAM(8);
    if (IN(9)) {
        sgemm_sample<0>(lds, (const bf16_t*)(ws + WS_B), (const bf16_t*)(ws + WS_WCO), 1024, p.out + (size_t)NTOKP * D, p.out, (bf16_t*)(ws + WS_A), (float*)(ws + WS_SSQ2), nullptr);
        pg8::Gemm g{(const bf16_t*)(ws + WS_B), (const bf16_t*)(ws + WS_WCO), NTOKP, 1024, 1024}; pg8::StaticOrder S; S.init(NTOKP, 1024, G, bid);
        EpiRes E{p.out, p.out + (size_t)NTOKP * D, p.out, (bf16_t*)(ws + WS_A), (float*)(ws + WS_SSQ2)}; pg8::gemm_phase(lds, g, S, E);
    }
    SEAM(9);
    if (IN(10)) REPS(10) { RSYNC();
        pg8::Gemm g{(const bf16_t*)(ws + WS_A), (const bf16_t*)(ws + WS_WFF13), NTOK, 5632, 1024}; pg8::StaticOrder S; S.init(NTOK, 5632, G, bid);
        EpiFF13 E{(bf16_t*)(ws + WS_PHG), (const float*)(ws + WS_SSQ2)}; pg8::gemm_phase(lds, g, S, E);
    }
    SEAM(10);
    if (IN(11)) {
        sgemm_sample<0>(lds, (const bf16_t*)(ws + WS_PHG), (const bf16_t*)(ws + WS_WFF2), 2816, p.out + (size_t)NTOKP * D, p.out, nullptr, nullptr, nullptr);
        pg8::Gemm g{(const bf16_t*)(ws + WS_PHG), (const bf16_t*)(ws + WS_WFF2), NTOKP, 1024, 2816}; pg8::StaticOrder S; S.init(NTOKP, 1024, G, bid);
        EpiRes E{p.out, p.out + (size_t)NTOKP * D, p.out, nullptr, nullptr}; pg8::gemm_phase(lds, g, S, E);
    }
    SEAM(11);
    if (IN(12)) ph_final(p);
#undef IN
#undef SEAM
}

extern "C" void kernel_launch(void* const* d_in, const int* in_sizes, int n_in, void* d_out, int out_size, void* d_ws, size_t ws_size, hipStream_t stream) {
    static int grid = 0;
    if (grid == 0) {
        if (n_in != 35 || ws_size < WS_END) { fprintf(stderr, "kernel_launch: unexpected n_in %d or ws %zu < %zu\n", n_in, ws_size, (size_t)WS_END); grid = -1; return; }
        if (hipFuncSetAttribute((const void*)mk_fwd, hipFuncAttributeMaxDynamicSharedMemorySize, LDS_BYTES) != hipSuccess) { fprintf(stderr, "kernel_launch: hipFuncSetAttribute failed\n"); grid = -1; return; }
        int dev = 0, cus = 0, per_cu = 0;
        hipGetDevice(&dev); hipDeviceGetAttribute(&cus, hipDeviceAttributeMultiprocessorCount, dev);
        hipOccupancyMaxActiveBlocksPerMultiprocessor(&per_cu, (const void*)mk_fwd, 512, LDS_BYTES);
        (void)hipGetLastError();
        if (per_cu < 1) per_cu = 1;
        grid = cus > 0 ? cus : 256;
    }
    if (grid < 0) return;
    if (hipMemsetAsync((char*)d_ws + WS_BAR, 0, 14080, stream) != hipSuccess) { fprintf(stderr, "kernel_launch: memset of the barrier word failed\n"); return; }
    Params p{};
    for (int i = 0; i < 35; ++i) p.in[i] = (const float*)d_in[i];
    p.out = (float*)d_out; p.ws = (unsigned char*)d_ws;
#if MK_MULTI
    for (int ph = 0; ph < NPHASE; ++ph) { p.lo = ph; p.hi = ph + 1; hipLaunchKernelGGL(mk_fwd, dim3(grid), dim3(512), LDS_BYTES, stream, p); }
#else
    p.lo = 0; p.hi = NPHASE;
    void* args[] = {&p};
    hipError_t e = hipLaunchCooperativeKernel((const void*)mk_fwd, dim3(grid), dim3(512), args, LDS_BYTES, stream);
    if (e != hipSuccess) fprintf(stderr, "cooperative launch failed: %s (grid %d)\n", hipGetErrorString(e), grid);
#endif
}
```
